# Optimizing an MI355X kernel written in HIP

```python
import math
import jax, jax.numpy as jnp
from jax import lax
import numpy as np

D_MODEL = 2048
BATCH = 16
SEQ = 2048
DEPTH = 1

HEAD_DIM = 64
D_A = D_MODEL // 2
D_B = D_MODEL - D_A
D_MIX = D_A + D_B
H_A = D_A // HEAD_DIM
KV_A = 2
G_A = H_A // KV_A
D_KV_A = KV_A * HEAD_DIM
H_B = D_B // HEAD_DIM
QKV_DIM = D_A + 2 * D_KV_A + 3 * D_B
WINDOW = 128
Q_BLOCK = 128
NUM_BUCKETS = 32
MAX_DISTANCE = 128
N_GROUPS = 4
EXPERTS_PER_GROUP = 8
N_EXPERTS = N_GROUPS * EXPERTS_PER_GROUP
TOP_K = 2
D_EXPERT = D_MODEL // 4
MOE_BLOCK = 128
ALPHA = (2.0 * DEPTH) ** 0.25
BETA = (8.0 * DEPTH) ** -0.25
ATTN_SCALE = 1.0 / math.sqrt(HEAD_DIM)
EPS = 1e-5
NEG_INF = -1e30

kernel_name = "hybrid_swa_sink_stickbreak_hmoe_deepnorm"


def layer_norm(x, g, b):
    xf = x.astype(jnp.float32)
    mu = jnp.mean(xf, axis=-1, keepdims=True)
    var = jnp.mean(jnp.square(xf - mu), axis=-1, keepdims=True)
    y = (xf - mu) * lax.rsqrt(var + EPS) * g.astype(jnp.float32) + b.astype(jnp.float32)
    return y.astype(x.dtype)


def rms_norm(x, g):
    xf = x.astype(jnp.float32)
    y = xf * lax.rsqrt(jnp.mean(jnp.square(xf), axis=-1, keepdims=True) + EPS)
    return (y * g.astype(jnp.float32)).astype(x.dtype)


def t5_bucket(dist):
    n = jnp.maximum(dist, 0)
    max_exact = NUM_BUCKETS // 2
    ratio = jnp.maximum(n, max_exact).astype(jnp.float32) / max_exact
    large = max_exact + (jnp.log(ratio) / math.log(MAX_DISTANCE / max_exact)
                         * (NUM_BUCKETS - max_exact)).astype(jnp.int32)
    large = jnp.minimum(large, NUM_BUCKETS - 1)
    return jnp.where(n < max_exact, n, large)


def sliding_sink_attention(q, k, v, sinks, rel_bias):
    B, S, _ = q.shape
    nb = S // WINDOW
    q = q.reshape(B, nb, WINDOW, KV_A, G_A, HEAD_DIM)
    k = k.reshape(B, nb, WINDOW, KV_A, HEAD_DIM)
    v = v.reshape(B, nb, WINDOW, KV_A, HEAD_DIM)
    pad = ((0, 0), (1, 0), (0, 0), (0, 0), (0, 0))
    kk = jnp.concatenate([jnp.pad(k, pad)[:, :-1], k], axis=2)
    vv = jnp.concatenate([jnp.pad(v, pad)[:, :-1], v], axis=2)
    scores = jnp.einsum('bnqhgd,bnkhd->bnhgqk', q, kk).astype(jnp.float32) * ATTN_SCALE
    qi = jnp.arange(WINDOW)[:, None]
    kj = jnp.arange(2 * WINDOW)[None, :]
    dist = qi + WINDOW - kj
    band = (dist >= 0) & (dist < WINDOW)
    not_first = (jnp.arange(nb)[:, None, None] > 0) | (kj >= WINDOW)[None]
    mask = band[None] & not_first
    bias = rel_bias[t5_bucket(dist)].astype(jnp.float32)
    bias = jnp.transpose(bias, (2, 0, 1)).reshape(KV_A, G_A, WINDOW, 2 * WINDOW)
    logits = jnp.where(mask[None, :, None, None], scores + bias, NEG_INF)
    sink = sinks.astype(jnp.float32).reshape(KV_A, G_A)[:, :, None, None]
    m = jnp.maximum(jnp.max(logits, axis=-1, keepdims=True), sink)
    p = jnp.exp(logits - m)
    probs = p / (jnp.sum(p, axis=-1, keepdims=True) + jnp.exp(sink - m))
    o = jnp.einsum('bnhgqk,bnkhd->bnqhgd', probs.astype(v.dtype), vv)
    return o.reshape(B, S, D_A)


def stick_breaking_attention(q, k, v):
    B, S, _ = q.shape
    q = q.reshape(B, S, H_B, HEAD_DIM).transpose(0, 2, 1, 3)
    k = k.reshape(B, S, H_B, HEAD_DIM).transpose(0, 2, 1, 3)
    v = v.reshape(B, S, H_B, HEAD_DIM).transpose(0, 2, 1, 3)
    outs = []
    for i in range(S // Q_BLOCK):
        end = (i + 1) * Q_BLOCK
        q_i = q[:, :, i * Q_BLOCK:end]
        k_i = k[:, :, :end]
        v_i = v[:, :, :end]
        t = i * Q_BLOCK + jnp.arange(Q_BLOCK)
        s = jnp.arange(end)
        mask = s[None, :] < t[:, None]
        z = jnp.einsum('bhqd,bhkd->bhqk', q_i, k_i).astype(jnp.float32) * ATTN_SCALE
        u = jnp.where(mask, jax.nn.log_sigmoid(-z), 0.0)
        suffix = lax.cumsum(u, axis=3, reverse=True) - u
        a = jnp.where(mask, jnp.exp(jax.nn.log_sigmoid(z) + suffix), 0.0)
        outs.append(jnp.einsum('bhqk,bhkd->bhqd', a.astype(v.dtype), v_i))
    o = jnp.concatenate(outs, axis=2)
    return o.transpose(0, 2, 1, 3).reshape(B, S, D_B)


def hybrid_mixer(h, w_in, w_out, sinks, rel_bias, norm_a, norm_b):
    qkv = h @ w_in
    cuts = np.cumsum([D_A, D_KV_A, D_KV_A, D_B, D_B]).tolist()
    q_a, k_a, v_a, q_b, k_b, v_b = jnp.split(qkv, cuts, axis=-1)
    o_a = rms_norm(sliding_sink_attention(q_a, k_a, v_a, sinks, rel_bias), norm_a)
    o_b = rms_norm(stick_breaking_attention(q_b, k_b, v_b), norm_b)
    return jnp.concatenate([o_a, o_b], axis=-1) @ w_out


def hierarchical_moe(h, w_grp, b_grp, w_rtr, b_rtr, w_gate, w_up, w_down):
    B, S, D = h.shape
    T = B * S
    xt = h.reshape(T, D)
    glog = (xt @ w_grp + b_grp).astype(jnp.float32)
    g_sel = jnp.argmax(glog, axis=-1)
    p_g = jnp.take_along_axis(jax.nn.softmax(glog, axis=-1), g_sel[:, None], axis=1)[:, 0]
    elog = (xt @ w_rtr + b_rtr).astype(jnp.float32).reshape(T, N_GROUPS, EXPERTS_PER_GROUP)
    elog = jnp.take_along_axis(elog, g_sel[:, None, None], axis=1)[:, 0]
    top_v, top_i = lax.top_k(elog, TOP_K)
    gates = p_g[:, None] * jax.nn.softmax(top_v, axis=-1)
    expert = g_sel[:, None].astype(jnp.int32) * EXPERTS_PER_GROUP + top_i.astype(jnp.int32)
    M = T * TOP_K
    e_flat = expert.reshape(M)
    tok_flat = jnp.arange(M, dtype=jnp.int32) // TOP_K
    order = jnp.argsort(e_flat)
    e_sorted = e_flat[order]
    tok_sorted = tok_flat[order]
    gate_sorted = gates.reshape(M)[order]
    counts = jax.ops.segment_sum(jnp.ones((M,), jnp.int32), e_flat, num_segments=N_EXPERTS)
    start = jnp.cumsum(counts) - counts
    padded = (counts + MOE_BLOCK - 1) // MOE_BLOCK * MOE_BLOCK
    pend = jnp.cumsum(padded)
    pstart = pend - padded
    dest = pstart[e_sorted] + (jnp.arange(M, dtype=jnp.int32) - start[e_sorted])
    m_pad = M + N_EXPERTS * MOE_BLOCK
    n_blk = m_pad // MOE_BLOCK
    slot_tok = jnp.full((m_pad,), T, jnp.int32).at[dest].set(tok_sorted)
    blk_expert = jnp.clip(jnp.searchsorted(pend, jnp.arange(n_blk) * MOE_BLOCK, side='right'),
                          0, N_EXPERTS - 1)
    x_pad = jnp.concatenate([xt, jnp.zeros((1, D), xt.dtype)], axis=0)
    xs = x_pad[slot_tok].reshape(n_blk, MOE_BLOCK, D)

    def expert_block(args):
        xb, e = args
        return (jax.nn.silu(xb @ w_gate[e]) * (xb @ w_up[e])) @ w_down[e]

    ys = lax.map(expert_block, (xs, blk_expert)).reshape(m_pad, D)
    y_assign = ys[dest] * gate_sorted[:, None].astype(ys.dtype)
    y = jax.ops.segment_sum(y_assign, tok_sorted, num_segments=T)
    return y.reshape(B, S, D)


def setup_inputs(seed: int = 0) -> dict:
    key = jax.random.key(seed)
    ks = jax.random.split(key, 24)
    f32 = jnp.float32
    D = D_MODEL
    nrm = lambda k, shape, s: jax.random.normal(k, shape, f32) * s
    x = nrm(ks[0], (BATCH, SEQ, D), 1.0)
    c = nrm(ks[1], (BATCH, D), 1.0)
    col_scale = jnp.concatenate([
        jnp.ones((D_A + D_KV_A,), f32), jnp.full((D_KV_A,), BETA, f32),
        jnp.ones((2 * D_B,), f32), jnp.full((D_B,), BETA, f32)])
    w_in = nrm(ks[2], (DEPTH, D, QKV_DIM), D ** -0.5) * col_scale
    w_out = nrm(ks[3], (DEPTH, D_MIX, D), BETA * D_MIX ** -0.5)
    sinks = nrm(ks[4], (DEPTH, H_A), 0.5)
    rel_bias = nrm(ks[5], (NUM_BUCKETS, H_A), 0.2)
    norm_a = 1.0 + nrm(ks[6], (DEPTH, D_A), 0.02)
    norm_b = 1.0 + nrm(ks[7], (DEPTH, D_B), 0.02)
    w_ada = nrm(ks[8], (DEPTH, D, 6 * D), 0.1 * D ** -0.5)
    b_ada = nrm(ks[9], (DEPTH, 6 * D), 0.02)
    ln1_g = 1.0 + nrm(ks[10], (DEPTH, D), 0.02)
    ln1_b = nrm(ks[11], (DEPTH, D), 0.02)
    ln2_g = 1.0 + nrm(ks[12], (DEPTH, D), 0.02)
    ln2_b = nrm(ks[13], (DEPTH, D), 0.02)
    w_grp = nrm(ks[14], (DEPTH, D, N_GROUPS), D ** -0.5)
    b_grp = nrm(ks[15], (DEPTH, N_GROUPS), 0.01)
    w_rtr = nrm(ks[16], (DEPTH, D, N_EXPERTS), D ** -0.5)
    b_rtr = nrm(ks[17], (DEPTH, N_EXPERTS), 0.01)
    w_gate = nrm(ks[18], (DEPTH, N_EXPERTS, D, D_EXPERT), BETA * D ** -0.5)
    w_up = nrm(ks[19], (DEPTH, N_EXPERTS, D, D_EXPERT), BETA * D ** -0.5)
    w_down = nrm(ks[20], (DEPTH, N_EXPERTS, D_EXPERT, D), BETA * D_EXPERT ** -0.5)
    return {"x": x, "c": c, "w_in": w_in, "w_out": w_out, "sinks": sinks,
            "rel_bias": rel_bias, "norm_a": norm_a, "norm_b": norm_b,
            "w_ada": w_ada, "b_ada": b_ada, "ln1_g": ln1_g, "ln1_b": ln1_b,
            "ln2_g": ln2_g, "ln2_b": ln2_b, "w_grp": w_grp, "b_grp": b_grp,
            "w_rtr": w_rtr, "b_rtr": b_rtr, "w_gate": w_gate, "w_up": w_up,
            "w_down": w_down}


def reference(x, c, w_in, w_out, sinks, rel_bias, norm_a, norm_b, w_ada, b_ada,
              ln1_g, ln1_b, ln2_g, ln2_b, w_grp, b_grp, w_rtr, b_rtr,
              w_gate, w_up, w_down):
    c_act = jax.nn.silu(c)
    for l in range(DEPTH):
        mod = c_act @ w_ada[l] + b_ada[l]
        shift1, scale1, gate1, shift2, scale2, gate2 = [
            m[:, None, :] for m in jnp.split(mod, 6, axis=-1)]
        h = x * (1.0 + scale1) + shift1
        mix = hybrid_mixer(h, w_in[l], w_out[l], sinks[l], rel_bias, norm_a[l], norm_b[l])
        x = layer_norm(ALPHA * x + (1.0 + gate1) * mix, ln1_g[l], ln1_b[l])
        h = x * (1.0 + scale2) + shift2
        ffn = hierarchical_moe(h, w_grp[l], b_grp[l], w_rtr[l], b_rtr[l],
                               w_gate[l], w_up[l], w_down[l])
        x = layer_norm(ALPHA * x + (1.0 + gate2) * ffn, ln2_g[l], ln2_b[l])
    return x
```

```cpp
#include <hip/hip_runtime.h>
#include <cstdio>
#include <cstdint>

constexpr int TOK = 32768, DM = 2048, SEQ = 2048, NBATCH = 16, QKVD = 4352;
constexpr int NEXP = 32, DEXP = 512, LCAP = 32768;
constexpr int MAXTILES = 288, SLOTS = MAXTILES * 256;
constexpr float ALPHA_DN = 1.189207115002721f;
constexpr float LN_EPS = 1e-5f;
constexpr float LOG2E = 1.4426950408889634f;
constexpr float W_GU_SCALE = 64.f, W_DN_SCALE = 32.f, ACT_SCALE = 8.f, YS_SCALE = 16.f;
constexpr float QSCALE = 0.125f * 1.4426950408889634f;
constexpr int COL_KA = 1024, COL_VA = 1152, COL_QB = 1280, COL_KB = 2304, COL_VB = 3328;

constexpr size_t MiB = 1u << 20;
constexpr size_t WS_CTL = 0, CTL_ZERO_BYTES = 96 * 1024;
constexpr size_t WS_MOD = 1 * MiB;
constexpr size_t WS_SSQ = 894 * MiB;
constexpr size_t WS_P4TAB = 2 * MiB;
constexpr size_t WS_PAIR = 3 * MiB;
constexpr size_t WS_WR = 4 * MiB;
constexpr size_t WS_STATS = 8 * MiB;
constexpr size_t WS_LIST = 16 * MiB;
constexpr size_t WS_WIN = 20 * MiB;
constexpr size_t WS_WOUT = 38 * MiB;
constexpr size_t WS_WGU = 46 * MiB;
constexpr size_t WS_WDN = 174 * MiB;
constexpr size_t WS_H = 238 * MiB;
constexpr size_t WS_QKV = 366 * MiB;
constexpr size_t WS_O = 638 * MiB;
constexpr size_t WS_ACT = 366 * MiB;
constexpr size_t WS_YS = 438 * MiB;
constexpr size_t WS_Y1 = 766 * MiB;
constexpr size_t WS_END = 898 * MiB;
static_assert(WS_WIN + (size_t)QKVD * DM * 2 <= WS_WOUT && WS_QKV + (size_t)TOK * QKVD * 2 <= WS_O && WS_ACT + (size_t)SLOTS * DEXP * 2 <= WS_YS && WS_YS + (size_t)SLOTS * DM * 2 <= WS_Y1 && WS_Y1 + (size_t)TOK * DM * 2 <= WS_SSQ && WS_SSQ + (size_t)TOK * 32 * 4 <= WS_END, "d_ws map");
constexpr int CW_BAR = 4096;
constexpr int CW_CNT = 16384;
static_assert((CW_CNT + 64 * 32) * 4 <= (int)CTL_ZERO_BYTES && (CW_BAR + 3456) * 4 <= CW_CNT * 4, "control words inside the per-call memset");

constexpr int RING_BYTES = 131072;
constexpr int MISC_OFF = RING_BYTES + 320;
constexpr int TBL_OFF = RING_BYTES + 1024;
constexpr int RS_OFF = RING_BYTES + 2048;
constexpr int RTE_OFF = RS_OFF + 8192;
constexpr int P4TAB_OFF = 142464;
constexpr int LDS_BYTES = 147456;
static_assert(RTE_OFF + 288 * 4 <= P4TAB_OFF && P4TAB_OFF + 4096 <= LDS_BYTES, "LDS map");

#define GAS __attribute__((address_space(1)))
#define LAS __attribute__((address_space(3)))
typedef unsigned short bf16;
typedef unsigned u32x4 __attribute__((ext_vector_type(4)));
typedef unsigned u32x2 __attribute__((ext_vector_type(2)));
typedef float f32x4 __attribute__((ext_vector_type(4)));
typedef float f32x2 __attribute__((ext_vector_type(2)));
typedef float f32x16 __attribute__((ext_vector_type(16)));
typedef short bf16x8 __attribute__((ext_vector_type(8)));
#define LDS_WAIT() asm volatile("s_waitcnt lgkmcnt(0)" ::: "memory")
#define VM_WAIT() asm volatile("s_waitcnt vmcnt(0)" ::: "memory")

__device__ __forceinline__ unsigned cvt_pk_bf16(float lo, float hi) { unsigned r; asm volatile("v_cvt_pk_bf16_f32 %0, %1, %2" : "=v"(r) : "v"(lo), "v"(hi)); return r; }
__device__ __forceinline__ unsigned cvt_fp8x4(float a, float b, float c, float d) { int w = 0; w = __builtin_amdgcn_cvt_pk_fp8_f32(a, b, w, false); w = __builtin_amdgcn_cvt_pk_fp8_f32(c, d, w, true); return (unsigned)w; }
__device__ __forceinline__ float bf_lo(unsigned w) { return __uint_as_float(w << 16); }
__device__ __forceinline__ float bf_hi(unsigned w) { return __uint_as_float(w & 0xffff0000u); }
#define DPP_ADD(v, ctrl) ((v) + __builtin_bit_cast(float, __builtin_amdgcn_update_dpp(0, __builtin_bit_cast(int, (v)), (ctrl), 0xf, 0xf, true)))
__device__ __forceinline__ float wave_sum(float v) {
    v = DPP_ADD(v, 0xB1); v = DPP_ADD(v, 0x4E); v = DPP_ADD(v, 0x141); v = DPP_ADD(v, 0x140);
    v += __shfl_xor(v, 16); v += __shfl_xor(v, 32);
    return v;
}
namespace pg8 {
#define PG8_LAS __attribute__((address_space(3)))
typedef unsigned short bf16_t;
constexpr int BM = 256, BK = 64, HALF = 128, HTB = HALF * BK * 2, STAGE_BYTES = 8 * HTB, NXCD = 8, WGM = 8;
__host__ __device__ __forceinline__ int lds_byte(int r, int c) { const int st = (r >> 4) * 2 + (c >> 5), rr = r & 15, cc = c & 31, ob = rr * 64 + cc * 2; return st * 1024 + (ob ^ (((ob >> 9) & 1) << 5)); }
__host__ __device__ __forceinline__ void stage_rc(int b, int& R, int& C) { const int st = b / 1024, sb = b % 1024, swz = sb ^ (((sb >> 9) & 1) << 5); R = (st >> 1) * 16 + swz / 64; C = (st & 1) * 32 + (swz % 64) / 2; }
__host__ __device__ __forceinline__ int perm32(int rho) { const int n = rho >> 4, i = rho & 15; return 8 * (i >> 2) + 4 * n + (i & 3); }

typedef int v8i32_t __attribute__((ext_vector_type(8))); typedef int v4i32_t __attribute__((ext_vector_type(4)));
__device__ __forceinline__ v8i32_t cat8(bf16x8 lo, bf16x8 hi) { const v4i32_t a = __builtin_bit_cast(v4i32_t, lo), b = __builtin_bit_cast(v4i32_t, hi); return __builtin_shufflevector(a, b, 0, 1, 2, 3, 4, 5, 6, 7); }
struct Unit { int pm, pn, e; };
template <class T, class = void> struct pg8_tab { static constexpr bool value = false; };
template <class T> struct pg8_tab<T, decltype((void)T::TABLE)> { static constexpr bool value = T::TABLE; };
struct Gemm { const bf16_t* A; const bf16_t* Bt; int K; size_t bexp; };

struct StaticOrder {
    int nM, nN, nwg, G, c;
    __device__ __forceinline__ void init(int M, int N, int G_, int c_) { nM = M / BM; nN = N / BM; nwg = nM * nN; G = G_; c = c_; }
    __device__ __forceinline__ bool next(int i, Unit& u) const {
        const long L = (long)i * G + c; if (L >= nwg) return false;
        int wgid = (int)L; { const int q = nwg / NXCD, r = nwg % NXCD, xcd = wgid % NXCD, off = wgid / NXCD; wgid = (xcd < r ? xcd * (q + 1) : r * (q + 1) + (xcd - r) * q) + off; }
        const int nig = WGM * nN, gid = wgid / nig, fm = gid * WGM, gsz = (nM - fm) < WGM ? (nM - fm) : WGM;
        u.pm = fm + ((wgid % nig) % gsz); u.pn = (wgid % nig) / gsz; u.e = 0; return true;
    }
    __device__ __forceinline__ unsigned row_off(int, int) const { return 0u; }
};

template <class Epi, class Sched, bool GATHER, bool MIDSCALE, bool FP8 = false>
__device__ __forceinline__ void gemm_phase(PG8_LAS unsigned char* lds, const Gemm g, const Sched& S, const Epi& E) {
    int tid_ = threadIdx.x; asm volatile("" : "+v"(tid_));
    const int tid = tid_, wid = __builtin_amdgcn_readfirstlane(tid >> 6), lane = tid & 63, wr = wid >> 2, wc = wid & 3, fr = lane & 15, fq = lane >> 4;
    int K_ = g.K; asm volatile("" : "+s"(K_));
    const int K = K_, nt = K / BK;
    unsigned voffA[2], voffB[2], voffB16[2][2]; int RA[2]; unsigned CA2[2];
#pragma unroll
    for (int i = 0; i < 2; ++i) { int R, C; stage_rc(tid * 16 + i * 8192, R, C); const int Rb = Epi::PERM ? ((R & ~31) + perm32(R & 31)) : R;
        voffA[i] = (unsigned)(R * K + C) * 2u; voffB[i] = (unsigned)(Rb * K + C) * 2u; RA[i] = R; CA2[i] = (unsigned)C * 2u;
        if constexpr (Epi::PERM16) {
#pragma unroll
            for (int h = 0; h < 2; ++h) { const int g16 = 64 * (R >> 5) + 16 * ((R >> 2) & 3) + 8 * h + 4 * ((R >> 4) & 1) + (R & 3); voffB16[h][i] = (unsigned)(g16 * K + C) * 2u; } } }
    const size_t kstep = (size_t)(BK * 2);
    const size_t hstep = (size_t)HALF * K * 2;
    const size_t tstep = 2 * hstep;
    const unsigned ldsw = (unsigned)wid * 1024u;
    const int aoff = lds_byte(wr * 64 + fr, fq * 8), boff = lds_byte(wc * 32 + fr, fq * 8);
#define PG8_SA(b, h) (((b) * 2 + (h)) * HTB)
#define PG8_SB(b, h) ((4 + (b) * 2 + (h)) * HTB)
#define PG8_STAGE(bufoff, gbase, voff) do { _Pragma("unroll") for (int _i = 0; _i < 2; ++_i) \
        __builtin_amdgcn_global_load_lds((const unsigned*)((const char*)(gbase) + (voff)[_i]), (PG8_LAS unsigned*)(lds + (bufoff) + ldsw + _i * 8192), 16, 0, 0); } while (0)
#define PG8_STB(bufoff, p, h) do { if constexpr (Epi::PERM16) { PG8_STAGE(bufoff, p, voffB16[h]); } else { PG8_STAGE(bufoff, (p) + (h) * hstep, voffB); } } while (0)
#define PG8_STA(bufoff, p, h, OFF) do { if constexpr (GATHER) { PG8_STAGE(bufoff, p, (OFF)[h]); } else { PG8_STAGE(bufoff, (p) + (h) * hstep, voffA); } } while (0)
#define PG8_LDA(dst, b, h) do { _Pragma("unroll") for (int m = 0; m < 4; ++m) { if constexpr (FP8) { dst##8[m] = cat8(*(const PG8_LAS bf16x8*)(lds + PG8_SA(b, h) + aoff + m * 2048), *(const PG8_LAS bf16x8*)(lds + PG8_SA(b, h) + aoff + m * 2048 + 1024)); } \
        else { _Pragma("unroll") for (int k = 0; k < 2; ++k) dst[m][k] = *(const PG8_LAS bf16x8*)(lds + PG8_SA(b, h) + aoff + m * 2048 + k * 1024); } } } while (0)
#define PG8_LDB(dst, b, h) do { _Pragma("unroll") for (int n = 0; n < 2; ++n) { if constexpr (FP8) { dst##8[n] = cat8(*(const PG8_LAS bf16x8*)(lds + PG8_SB(b, h) + boff + n * 2048), *(const PG8_LAS bf16x8*)(lds + PG8_SB(b, h) + boff + n * 2048 + 1024)); } \
        else { _Pragma("unroll") for (int k = 0; k < 2; ++k) dst[n][k] = *(const PG8_LAS bf16x8*)(lds + PG8_SB(b, h) + boff + n * 2048 + k * 1024); } } } while (0)
#define PG8_MMA(ai, bj, At, Bt) do { __builtin_amdgcn_s_setprio(1); _Pragma("unroll") for (int m = 0; m < 4; ++m) _Pragma("unroll") for (int n = 0; n < 2; ++n) { \
        if constexpr (FP8) { asm volatile("v_mfma_scale_f32_16x16x128_f8f6f4 %0, %1, %2, %0, %3, %3 op_sel_hi:[0,0,0]" : "+v"(acc[ai][bj][m][n]) : "v"(Bt##8[n]), "v"(At##8[m]), "v"(fp8_one)); } \
        else { _Pragma("unroll") for (int k = 0; k < 2; ++k) acc[ai][bj][m][n] = __builtin_amdgcn_mfma_f32_16x16x32_bf16(Bt[n][k], At[m][k], acc[ai][bj][m][n], 0, 0, 0); } } \
        __builtin_amdgcn_s_setprio(0); } while (0)
#define PG8_WAIT_V(n) asm volatile("s_waitcnt vmcnt(" #n ")" ::: "memory")
#define PG8_WAIT_V8T() do { if constexpr (pg8_tab<Epi>::value) { if (t == 2) PG8_WAIT_V(10); else PG8_WAIT_V(8); } else PG8_WAIT_V(8); } while (0)
#define PG8_WAIT_L(n) asm volatile("s_waitcnt lgkmcnt(" #n ")" ::: "memory")
#define PG8_BAR __builtin_amdgcn_s_barrier()
#define PG8_SCHED __builtin_amdgcn_sched_barrier(0)
    Unit cur, nxt; int ui = 0;
    if (!S.next(0, cur)) return;
    f32x4 acc[2][2][4][2];
#pragma unroll
    for (int a = 0; a < 2; ++a)
#pragma unroll
        for (int b = 0; b < 2; ++b)
#pragma unroll
            for (int m = 0; m < 4; ++m)
#pragma unroll
                for (int n = 0; n < 2; ++n) acc[a][b][m][n] = (f32x4){0.f, 0.f, 0.f, 0.f};
    bf16x8 At[4][2], B0[2][2], B1[2][2]; v8i32_t At8[4], B08[2], B18[2];
    const int fp8_one = 0x7F7F7F7F;
    unsigned offC[2][2], offN[2][2];
    if constexpr (GATHER) {
#pragma unroll
        for (int h = 0; h < 2; ++h)
#pragma unroll
            for (int i = 0; i < 2; ++i) { offC[h][i] = S.row_off(0, RA[i] + HALF * h) + CA2[i]; offN[h][i] = offC[h][i]; }
    }
    const char* cA = GATHER ? (const char*)g.A : (const char*)g.A + (size_t)cur.pm * tstep;
    const char* cB = (const char*)g.Bt + (size_t)cur.e * g.bexp + (size_t)cur.pn * tstep;
    PG8_STB(PG8_SB(0, 0), cB, 0); PG8_STB(PG8_SB(0, 1), cB, 1); PG8_STA(PG8_SA(0, 0), cA, 0, offC); PG8_STA(PG8_SA(0, 1), cA, 1, offC);
    if (wr == 1) PG8_BAR;
    PG8_WAIT_V(2); PG8_BAR;
    PG8_STB(PG8_SB(1, 0), cB + kstep, 0); PG8_STA(PG8_SA(1, 0), cA + kstep, 0, offC); PG8_STB(PG8_SB(1, 1), cB + kstep, 1);
    PG8_WAIT_V(6); PG8_BAR;
    for (;;) {
        const bool has_next = S.next(ui + 1, nxt);
        const char* nA = GATHER ? (const char*)g.A : (has_next ? (const char*)g.A + (size_t)nxt.pm * tstep : cA);
        const char* nB = has_next ? (const char*)g.Bt + (size_t)nxt.e * g.bexp + (size_t)nxt.pn * tstep : cB;
        if constexpr (GATHER) {
            if (has_next) {
#pragma unroll
                for (int h = 0; h < 2; ++h)
#pragma unroll
                    for (int i = 0; i < 2; ++i) offN[h][i] = S.row_off(ui + 1, RA[i] + HALF * h) + CA2[i];
            } else {
#pragma unroll
                for (int h = 0; h < 2; ++h)
#pragma unroll
                    for (int i = 0; i < 2; ++i) offN[h][i] = offC[h][i];
            }
        }
        _Pragma("nounroll") for (int t = 0; t < nt; t += 2) {
            const bool last = (t == nt - 2);
            const char* a1 = cA + (size_t)(t + 1) * kstep;
            const char* a2 = last ? nA : cA + (size_t)(t + 2) * kstep; const char* b2 = last ? nB : cB + (size_t)(t + 2) * kstep;
            const char* a3 = a2 + kstep; const char* b3 = b2 + kstep;
            unsigned o2[2][2];
            if constexpr (GATHER) {
#pragma unroll
                for (int h = 0; h < 2; ++h)
#pragma unroll
                    for (int i = 0; i < 2; ++i) o2[h][i] = last ? offN[h][i] : offC[h][i];
            }
            if constexpr (MIDSCALE) { if (t == nt / 2) E.midscale(acc, ui, wr, fr); }
            PG8_LDB(B0, 0, 0); PG8_LDB(B1, 0, 1); PG8_SCHED; PG8_LDA(At, 0, 0); PG8_STA(PG8_SA(1, 1), a1, 1, offC);
            if constexpr (pg8_tab<Epi>::value) { if (t == 2) E.table_issue(lds, cur, wid, lane); }
            PG8_WAIT_V8T(); PG8_WAIT_L(0); PG8_BAR; PG8_MMA(0, 0, At, B0); PG8_MMA(0, 1, At, B1); PG8_BAR; PG8_SCHED;
            PG8_LDA(At, 0, 1); PG8_STB(PG8_SB(0, 0), b2, 0); PG8_STB(PG8_SB(0, 1), b2, 1); PG8_STA(PG8_SA(0, 0), a2, 0, o2);
            PG8_WAIT_V8T(); PG8_WAIT_L(0); PG8_BAR; PG8_MMA(1, 0, At, B0); PG8_MMA(1, 1, At, B1); PG8_BAR; PG8_SCHED;
            PG8_LDB(B0, 1, 0); PG8_LDB(B1, 1, 1); PG8_SCHED; PG8_LDA(At, 1, 0); PG8_STA(PG8_SA(0, 1), a2, 1, o2);
            PG8_WAIT_V(8); PG8_WAIT_L(0); PG8_BAR; PG8_MMA(0, 0, At, B0); PG8_MMA(0, 1, At, B1); PG8_BAR; PG8_SCHED;
            PG8_LDA(At, 1, 1); PG8_STB(PG8_SB(1, 0), b3, 0); PG8_STB(PG8_SB(1, 1), b3, 1); PG8_STA(PG8_SA(1, 0), a3, 0, o2);
            PG8_WAIT_V(8); PG8_WAIT_L(0); PG8_BAR; PG8_MMA(1, 0, At, B0); PG8_MMA(1, 1, At, B1); PG8_BAR; PG8_SCHED;
        }
        if (wr == 0) PG8_BAR;
        if constexpr (FP8) {
#pragma unroll
            for (int a = 0; a < 2; ++a)
#pragma unroll
                for (int b = 0; b < 2; ++b)
                    asm volatile("s_nop 15\n\ts_nop 15" : "+v"(acc[a][b][0][0]), "+v"(acc[a][b][0][1]), "+v"(acc[a][b][1][0]), "+v"(acc[a][b][1][1]), "+v"(acc[a][b][2][0]), "+v"(acc[a][b][2][1]), "+v"(acc[a][b][3][0]), "+v"(acc[a][b][3][1]));
        }
        E(acc, cur, ui, wr, wc, fr, fq);
        if (!has_next) break;
#pragma unroll
        for (int a = 0; a < 2; ++a)
#pragma unroll
            for (int b = 0; b < 2; ++b)
#pragma unroll
                for (int m = 0; m < 4; ++m)
#pragma unroll
                    for (int n = 0; n < 2; ++n) acc[a][b][m][n] = (f32x4){0.f, 0.f, 0.f, 0.f};
        cur = nxt; cA = nA; cB = nB; ++ui;
        if constexpr (GATHER) {
#pragma unroll
            for (int h = 0; h < 2; ++h)
#pragma unroll
                for (int i = 0; i < 2; ++i) offC[h][i] = offN[h][i];
        }
        if (wr == 1) PG8_BAR;
    }
    PG8_WAIT_V(0);
    PG8_BAR;
#undef PG8_SA
#undef PG8_SB
#undef PG8_STAGE
#undef PG8_STA
#undef PG8_STB
#undef PG8_LDA
#undef PG8_LDB
#undef PG8_MMA
#undef PG8_WAIT_V
#undef PG8_WAIT_V8T
#undef PG8_WAIT_L
#undef PG8_BAR
#undef PG8_SCHED
}
}

#define XB_TMO      128
#define XB_XCNT(j)  (256  + 64 * (j))
#define XB_XSUB(j)  (1280 + 64 * (j))
#define XB_XGEN(j)  (2304 + 64 * (j))
#define XB_TOP      3328
#define XB_TOPGEN   3392
#define XCD_BAR_WORDS 3456
#define XB_SPIN_CAP (1u << 18)

__device__ __forceinline__ unsigned xb_ld(unsigned* p)              { return __hip_atomic_load(p, __ATOMIC_RELAXED, __HIP_MEMORY_SCOPE_AGENT); }
__device__ __forceinline__ unsigned xb_add(unsigned* p, unsigned v) { return __hip_atomic_fetch_add(p, v, __ATOMIC_RELAXED, __HIP_MEMORY_SCOPE_AGENT); }
__device__ __forceinline__ unsigned xb_xcc_id() { return (unsigned)__builtin_amdgcn_s_getreg((3 << 11) | 20) & 0xFu; }
#define XB_SPIN(cond, bar) do { unsigned _sp = 0; while (cond) { __builtin_amdgcn_s_sleep(1); \
    if ((++_sp & 255u) == 0u) { if (xb_ld(&(bar)[XB_TMO])) break; if (_sp > XB_SPIN_CAP) { atomicAdd(&(bar)[XB_TMO], 1u); break; } } } } while (0)

struct XcdBarrier {
    unsigned* bar; unsigned x;
    volatile LAS unsigned* st;
};
__device__ __forceinline__ XcdBarrier xcd_barrier_post(unsigned* bar, volatile LAS unsigned* st) {
    XcdBarrier b; b.bar = bar; b.x = xb_xcc_id(); b.st = st;
    if (threadIdx.x == 0) (void)xb_add(&bar[XB_XCNT(b.x)], 1u);
    return b;
}
__device__ __forceinline__ void xcd_barrier_complete(unsigned* bar, unsigned x, unsigned& nloc, unsigned& nx) {
    const unsigned G = gridDim.x * gridDim.y * gridDim.z;
    unsigned sum, cnt, mine, sp = 0u;
    for (;;) {
        sum = 0u; cnt = 0u; mine = 0u;
#pragma unroll
        for (unsigned j = 0; j < 16; ++j) { const unsigned c = xb_ld(&bar[XB_XCNT(j)]); sum += c; cnt += (c > 0u) ? 1u : 0u; mine = (j == x) ? c : mine; }
        if (sum == G) break;
        __builtin_amdgcn_s_sleep(1);
        if ((++sp & 255u) == 0u) { if (xb_ld(&bar[XB_TMO])) break; if (sp > XB_SPIN_CAP) { atomicAdd(&bar[XB_TMO], 1u); break; } }
    }
    nloc = mine > 0u ? mine : 1u; nx = cnt > 0u ? cnt : 1u;
}
__device__ __forceinline__ void xcd_barrier(const XcdBarrier& b) {
    asm volatile("s_waitcnt vmcnt(0)" ::: "memory");
    __syncthreads();
    if (threadIdx.x == 0) {
        unsigned* bar = b.bar;
        __builtin_amdgcn_s_waitcnt(0);
        unsigned nloc = b.st[0], nx = b.st[1];
        if (nloc == 0u) { xcd_barrier_complete(bar, b.x, nloc, nx); b.st[0] = nloc; b.st[1] = nx; }
        const unsigned old = xb_add(&bar[XB_XSUB(b.x)], 1u);
        const unsigned gen = old / nloc;
        if (old + 1u == (gen + 1u) * nloc) {
            __builtin_amdgcn_fence(__ATOMIC_RELEASE, "agent");
            asm volatile("s_waitcnt vmcnt(0)" ::: "memory");
            const unsigned og = xb_add(&bar[XB_TOP], 1u);
            const unsigned tg = og / nx;
            if (og + 1u == (tg + 1u) * nx) xb_add(&bar[XB_TOPGEN], 1u);
            else XB_SPIN(xb_ld(&bar[XB_TOPGEN]) == tg, bar);
            __builtin_amdgcn_fence(__ATOMIC_ACQUIRE, "agent");
            xb_add(&bar[XB_XGEN(b.x)], 1u);
            asm volatile("s_waitcnt vmcnt(0)" ::: "memory");
        } else {
            XB_SPIN(xb_ld(&bar[XB_XGEN(b.x)]) == gen, bar);
            __builtin_amdgcn_fence(__ATOMIC_ACQUIRE, "agent");
            asm volatile("s_waitcnt vmcnt(0)" ::: "memory");
        }
    }
    __syncthreads();
}

struct Frame {
    LAS unsigned char* lds;
    unsigned* ctl;
    int tid, lane, wave, vcu, G;
    const float* const* in;
    float* out; unsigned char* ws;
};
#define IN_x (F.in[0])
#define IN_c (F.in[1])
#define IN_w_in (F.in[2])
#define IN_w_out (F.in[3])
#define IN_sinks (F.in[4])
#define IN_rel_bias (F.in[5])
#define IN_norm_a (F.in[6])
#define IN_norm_b (F.in[7])
#define IN_w_ada (F.in[8])
#define IN_b_ada (F.in[9])
#define IN_ln1_g (F.in[10])
#define IN_ln1_b (F.in[11])
#define IN_ln2_g (F.in[12])
#define IN_ln2_b (F.in[13])
#define IN_w_grp (F.in[14])
#define IN_b_grp (F.in[15])
#define IN_w_rtr (F.in[16])
#define IN_b_rtr (F.in[17])
#define IN_w_gate (F.in[18])
#define IN_w_up (F.in[19])
#define IN_w_down (F.in[20])

struct CvtItem { const float* src; const float* kgain; bf16* dst0; int ldw, ldd; float scol; };
__device__ __forceinline__ void cvt_load(const CvtItem& it, f32x4 (&a)[8], f32x4 (&b)[8], int lane) {
#pragma unroll
    for (int i = 0; i < 8; ++i) { const int idx = lane + 64 * i, kk2 = idx >> 4, c4 = idx & 15; const float* p = it.src + (size_t)(2 * kk2) * it.ldw + 4 * c4;
        a[i] = __builtin_nontemporal_load((const f32x4*)p); b[i] = __builtin_nontemporal_load((const f32x4*)(p + it.ldw)); }
}
__device__ __forceinline__ void cvt_store(const CvtItem& it, const f32x4 (&a)[8], const f32x4 (&b)[8], LAS unsigned* img, int lane) {
#pragma unroll
    for (int i = 0; i < 8; ++i) { const int idx = lane + 64 * i, kk2 = idx >> 4, c4 = idx & 15; float ga = it.scol, gb = it.scol;
        if (it.kgain) { ga *= it.kgain[2 * kk2]; gb *= it.kgain[2 * kk2 + 1]; }
#pragma unroll
        for (int j = 0; j < 4; ++j) img[(4 * c4 + j) * 33 + kk2] = cvt_pk_bf16(a[i][j] * ga, b[i][j] * gb); }
    LDS_WAIT(); asm volatile("" ::: "memory");
#pragma unroll
    for (int i = 0; i < 8; ++i) { const int idx = lane + 64 * i, n = idx >> 3, ch = idx & 7; const LAS unsigned* s = img + n * 33 + 4 * ch;
        u32x4 v; v.x = s[0]; v.y = s[1]; v.z = s[2]; v.w = s[3];
        *(u32x4*)(it.dst0 + (size_t)n * it.ldd + 8 * ch) = v; }
    LDS_WAIT(); asm volatile("" ::: "memory");
}
constexpr int CVT_I_IN = 32 * 68, CVT_I_OUT = 32 * 32, CVT_NITEMS = CVT_I_IN + CVT_I_OUT;
__device__ __forceinline__ CvtItem cvt_decode(Frame& F, int r) {
    bf16* WIN = (bf16*)(F.ws + WS_WIN); bf16* WOUT = (bf16*)(F.ws + WS_WOUT);
    CvtItem it;
    if (r < CVT_I_IN) { const int kb = r / 68, nb = r % 68, n0 = 64 * nb; it.scol = (n0 < 1024 || (n0 >= COL_QB && n0 < COL_KB)) ? QSCALE : 1.f;
        it.src = IN_w_in + (size_t)(64 * kb) * QKVD + n0; it.ldw = QKVD; it.kgain = nullptr; it.dst0 = WIN + (size_t)n0 * DM + 64 * kb; it.ldd = DM; return it; }
    r -= CVT_I_IN;
    { const int kb = r / 32, nb = r % 32, k0 = 64 * kb; it.scol = 1.f; it.kgain = k0 < 1024 ? IN_norm_a + k0 : IN_norm_b + (k0 - 1024);
      it.src = IN_w_out + (size_t)k0 * DM + 64 * nb; it.ldw = DM; it.dst0 = WOUT + (size_t)(64 * nb) * DM + k0; it.ldd = DM; return it; }
}
__device__ __forceinline__ void cvt8_item(const float* __restrict__ src, int ldw, float scol, unsigned char* dst0, int ldd, LAS unsigned* img, int lane) {
    f32x4 v[8][4];
#pragma unroll
    for (int i = 0; i < 8; ++i) { const int idx = lane + 64 * i, kk4 = idx >> 4, c4 = idx & 15; const float* p = src + (size_t)(4 * kk4) * ldw + 4 * c4;
#pragma unroll
        for (int q = 0; q < 4; ++q) v[i][q] = __builtin_nontemporal_load((const f32x4*)(p + (size_t)q * ldw)); }
#pragma unroll
    for (int i = 0; i < 8; ++i) { const int idx = lane + 64 * i, kk4 = idx >> 4, c4 = idx & 15;
#pragma unroll
        for (int j = 0; j < 4; ++j) img[(4 * c4 + j) * 33 + kk4] = cvt_fp8x4(v[i][0][j] * scol, v[i][1][j] * scol, v[i][2][j] * scol, v[i][3][j] * scol); }
    LDS_WAIT(); asm volatile("" ::: "memory");
#pragma unroll
    for (int i = 0; i < 8; ++i) { const int idx = lane + 64 * i, n = idx >> 3, ch = idx & 7; const LAS unsigned* sp = img + n * 33 + 4 * ch;
        u32x4 w; w.x = sp[0]; w.y = sp[1]; w.z = sp[2]; w.w = sp[3];
        *(u32x4*)(dst0 + (size_t)n * ldd + 16 * ch) = w; }
    LDS_WAIT(); asm volatile("" ::: "memory");
}

constexpr int CVT8_PRE2 = 2;
constexpr int CVT8_EXTRA = 1024;
constexpr int CVT8_N = 2 * 32 * 16 * 8 + 32 * 4 * 32, CVT8_DEFER2 = 5120, CVT8_DEFER6 = 3328, CVT8_DEFER4 = 2048, QKV_UNITS = (TOK / 256) * (QKVD / 256);
static_assert(CVT8_N - CVT8_DEFER6 >= 2 * 32 * 16 * 8, "the items deferred to the gate/up phase must be down-projection tiles");
__device__ __forceinline__ int cvt8_short(int G) { const int rem = QKV_UNITS % G; return rem == 0 ? 0 : G - rem; }
__device__ __forceinline__ int cvt8_split(int G) { return CVT8_N - CVT8_DEFER6 - (cvt8_short(G) > 0 ? CVT8_DEFER2 : 0) - CVT8_DEFER4; }
__device__ __forceinline__ void cvt8_run(Frame& F, int r, LAS unsigned* img, int lane) {
    unsigned char* WGU = F.ws + WS_WGU; unsigned char* WDN = F.ws + WS_WDN;
    constexpr int I_G = 32 * 16 * 8;
    if (r < 2 * I_G) { const int up = r >= I_G, rr = up ? r - I_G : r; const int e = rr / 128, q = rr % 128, kb = q / 8, nb = q % 8, j0 = 64 * nb;
        const int drow = 256 * (j0 >> 7) + (up ? 128 : 0) + (j0 & 127);
        cvt8_item((up ? IN_w_up : IN_w_gate) + (size_t)e * DM * DEXP + (size_t)(128 * kb) * DEXP + j0, DEXP, W_GU_SCALE, WGU + ((size_t)e * 1024 + drow) * DM + 128 * kb, DM, img, lane);
    } else { const int rr = r - 2 * I_G; const int e = rr / 128, q = rr % 128, kb = q / 32, nb = q % 32;
        cvt8_item(IN_w_down + (size_t)e * DEXP * DM + (size_t)(128 * kb) * DM + 64 * nb, DM, W_DN_SCALE, WDN + ((size_t)e * DM + 64 * nb) * DEXP + 128 * kb, DEXP, img, lane); }
}
__device__ __forceinline__ void cvt8_deferred2(Frame& F, int part) {
    const int ns = cvt8_short(F.G), first = F.G - ns, c = (int)blockIdx.x;
    int lane = F.lane; asm volatile("" : "+v"(lane));
    if (ns > 0 && c >= first) { LAS unsigned* img = (LAS unsigned*)(F.lds + F.wave * 8448); const int lo = cvt8_split(F.G) + CVT8_DEFER4, hi = lo + CVT8_DEFER2, stride = ns * 8;
        const int r0 = lo + (c - first) * 8 + F.wave, rmid = r0 + CVT8_PRE2 * stride;
        if (part == 0) { for (int r = r0; r < hi && r < rmid; r += stride) cvt8_run(F, r, img, lane); }
        else { for (int r = rmid; r < hi; r += stride) cvt8_run(F, r, img, lane); } }
}
__device__ __forceinline__ void cvt8_deferred4(Frame& F) {
    int lane = F.lane; asm volatile("" : "+v"(lane));
    if (F.vcu & 1) { LAS unsigned* img = (LAS unsigned*)(F.lds + F.wave * 8448); const int lo = cvt8_split(F.G), hi = lo + CVT8_DEFER4;
        for (int r = lo + (F.vcu >> 1) * 8 + F.wave; r < hi; r += (F.G >> 1) * 8) cvt8_run(F, r, img, lane); }
}
__device__ __forceinline__ void cvt8_deferred6(Frame& F, int units) {
    const int rem = units % F.G, ns = F.G - rem; const bool all = rem == 0 || ns < 64;
    int lane = F.lane; asm volatile("" : "+v"(lane));
    const int idx = all ? F.vcu : F.vcu - rem, cnt = all ? F.G : ns;
    if (idx >= 0) { LAS unsigned* img = (LAS unsigned*)(F.lds + F.wave * 8448);
        for (int r = CVT8_N - CVT8_DEFER6 + idx * 8 + F.wave; r < CVT8_N; r += cnt * 8) cvt8_run(F, r, img, lane); }
}
__device__ __forceinline__ void p0_prologue(Frame& F) {
    float* mod = (float*)(F.ws + WS_MOD);
    const bool spread = (F.G == 256); const bool freewg = spread && (F.vcu & 3) == 3;
    for (int ab = spread ? (freewg ? 192 : (F.vcu >> 2) * 3 + (F.vcu & 3)) : F.vcu; ab < 192; ab += spread ? 192 : F.G) {
        LAS float* cact = (LAS float*)F.lds;
        for (int idx = F.tid; idx < 16 * 2048; idx += 512) { const int b = idx >> 11, k = idx & 2047; const float v = IN_c[idx]; cact[k * 16 + b] = v * __builtin_amdgcn_rcpf(1.f + __builtin_amdgcn_exp2f(-v * LOG2E)); }
        __syncthreads();
        const int cc = F.lane & 15, kk = F.lane >> 4;
        f32x4 acc[4];
#pragma unroll
        for (int j = 0; j < 4; ++j) acc[j] = (f32x4){0.f, 0.f, 0.f, 0.f};
        const float* wp = IN_w_ada + 64 * ab + 4 * cc + (size_t)(256 * F.wave + kk) * 12288;
        const LAS float* ap = cact + (256 * F.wave + kk) * 16 + cc;
#pragma unroll 16
        for (int st = 0; st < 64; ++st) { const f32x4 w = __builtin_nontemporal_load((const f32x4*)(wp + (size_t)(4 * st) * 12288)); const float av = ap[4 * st * 16];
#pragma unroll
            for (int j = 0; j < 4; ++j) acc[j] = __builtin_amdgcn_mfma_f32_16x16x4f32(av, w[j], acc[j], 0, 0, 0); }
        __syncthreads();
        LAS float* red = (LAS float*)F.lds;
#pragma unroll
        for (int j = 0; j < 4; ++j)
#pragma unroll
            for (int r = 0; r < 4; ++r) red[(F.wave * 16 + 4 * kk + r) * 64 + 4 * cc + j] = acc[j][r];
        __syncthreads();
        for (int o = F.tid; o < 1024; o += 512) { const int b = o >> 6, col = o & 63; float sm = 0.f;
#pragma unroll
            for (int w = 0; w < 8; ++w) sm += red[(w * 16 + b) * 64 + col];
            mod[b * 12288 + 64 * ab + col] = sm + IN_b_ada[64 * ab + col]; }
        __syncthreads();
    }
    { bf16* wh = (bf16*)(F.ws + WS_WR); bf16* wl = wh + 48 * 2048;
      for (int idx = F.vcu * 512 + F.tid; idx < 48 * 2048; idx += F.G * 512) { const int c = idx >> 11, k = idx & 2047;
          const float v = c < 4 ? IN_w_grp[k * 4 + c] : (c < 36 ? IN_w_rtr[k * 32 + (c - 4)] : 0.f);
          const unsigned h = cvt_pk_bf16(v, 0.f) & 0xffffu; const float r = v - bf_lo(h);
          wh[idx] = (bf16)h; wl[idx] = (bf16)(cvt_pk_bf16(r, 0.f) & 0xffffu); } }
    LAS unsigned* img = (LAS unsigned*)(F.lds + F.wave * 8448);
    const int gw = F.vcu * 8 + F.wave, NGW = F.G * 8;
    f32x4 a0[8], b0[8], a1[8], b1[8]; CvtItem i0, i1;
    int it = gw;
    if (it < CVT_NITEMS) { i0 = cvt_decode(F, it); cvt_load(i0, a0, b0, F.lane); }
    for (; it < CVT_NITEMS; it += 2 * NGW) {
        const bool h1 = it + NGW < CVT_NITEMS, h2 = it + 2 * NGW < CVT_NITEMS;
        if (h1) { i1 = cvt_decode(F, it + NGW); cvt_load(i1, a1, b1, F.lane); }
        cvt_store(i0, a0, b0, img, F.lane);
        if (h2) { i0 = cvt_decode(F, it + 2 * NGW); cvt_load(i0, a0, b0, F.lane); }
        if (h1) cvt_store(i1, a1, b1, img, F.lane);
    }
    const int n0 = cvt8_split(F.G), ex = spread ? CVT8_EXTRA : 0;
    if (freewg) for (int r = (F.vcu >> 2) * 8 + F.wave; r < ex; r += 512) cvt8_run(F, r, img, F.lane);
    for (int r = ex + gw; r < n0; r += NGW) cvt8_run(F, r, img, F.lane);
}

__device__ __forceinline__ void p1_modulate(Frame& F) {
    const float* mod = (const float*)(F.ws + WS_MOD); bf16* H = (bf16*)(F.ws + WS_H);
    LAS float* sc = (LAS float*)F.lds; LAS float* sh = sc + 2048;
    for (int blk = F.vcu; blk < 256; blk += F.G) {
        const int b = blk >> 4;
        for (int k = F.tid; k < 2048; k += 512) { sc[k] = 1.f + mod[b * 12288 + 2048 + k]; sh[k] = mod[b * 12288 + k]; }
        if ((blk & 15) == 0) { float* T = (float*)(F.ws + WS_P4TAB) + (size_t)b * 4 * 2048;
            for (int k = F.tid; k < 2048; k += 512) { const float ca = ALPHA_DN / (1.f + mod[b * 12288 + 2048 + k]); T[k] = ca; T[2048 + k] = -mod[b * 12288 + k] * ca; T[4096 + k] = 1.f + mod[b * 12288 + 4096 + k]; T[6144 + k] = 0.f; } }
        __syncthreads();
        for (int r = F.wave; r < 128; r += 16) { const size_t row = (size_t)blk * 128 + r;
            f32x4 xv[2][8];
#pragma unroll
            for (int q = 0; q < 2; ++q)
#pragma unroll
                for (int j = 0; j < 8; ++j) xv[q][j] = __builtin_nontemporal_load((const f32x4*)(IN_x + (row + 8 * q) * DM + 4 * F.lane + 256 * j));
#pragma unroll
            for (int q = 0; q < 2; ++q)
#pragma unroll
                for (int j = 0; j < 8; ++j) { const int col = 4 * F.lane + 256 * j;
                    const f32x4 s4 = *(const LAS f32x4*)(sc + col), t4 = *(const LAS f32x4*)(sh + col); const f32x4 h = xv[q][j] * s4 + t4;
                    u32x2 w; w.x = cvt_pk_bf16(h[0], h[1]); w.y = cvt_pk_bf16(h[2], h[3]); *(u32x2*)(H + (row + 8 * q) * DM + col) = w; } }
        __syncthreads();
    }
}

struct EpiStoreBf16 {
    static constexpr bool PERM = true, PERM16 = true;
    bf16* O; int ldc; float sc;
    __device__ __forceinline__ void operator()(const f32x4 (&acc)[2][2][4][2], const pg8::Unit& u, int ui, int wr, int wc, int fr, int fq) const {
        const int bb = (u.pm * 256) >> 11, s0 = (u.pm * 256) & 2047;
        bf16* base = O + (((size_t)(u.pn * 4 + wc) * NBATCH + bb) * SEQ + s0 + wr * 64 + fr) * 64 + 16 * fq;
#pragma unroll
        for (int ai = 0; ai < 2; ++ai)
#pragma unroll
            for (int m = 0; m < 4; ++m) { bf16* rowp = base + (size_t)(ai * 128 + m * 16) * 64;
#pragma unroll
                for (int bj = 0; bj < 2; ++bj) { const f32x4 v0 = acc[ai][bj][m][0] * sc, v1 = acc[ai][bj][m][1] * sc;
                    u32x4 w; w.x = cvt_pk_bf16(v0[0], v0[1]); w.y = cvt_pk_bf16(v0[2], v0[3]); w.z = cvt_pk_bf16(v1[0], v1[1]); w.w = cvt_pk_bf16(v1[2], v1[3]);
                    *(u32x4*)(rowp + bj * 8) = w; } }
    }
};
struct EpiStoreFp8 {
    static constexpr bool PERM = true, PERM16 = true;
    unsigned char* O; int ldc; float sc;
    __device__ __forceinline__ void operator()(const f32x4 (&acc)[2][2][4][2], const pg8::Unit& u, int ui, int wr, int wc, int fr, int fq) const {
        const int row0 = u.pm * 256 + wr * 64 + fr, col0 = u.pn * 256 + wc * 64 + 16 * fq;
#pragma unroll
        for (int ai = 0; ai < 2; ++ai)
#pragma unroll
            for (int m = 0; m < 4; ++m) { unsigned char* rowp = O + (size_t)(row0 + ai * 128 + m * 16) * ldc + col0;
                const f32x4 a0 = acc[ai][0][m][0] * sc, a1 = acc[ai][0][m][1] * sc, b0 = acc[ai][1][m][0] * sc, b1 = acc[ai][1][m][1] * sc;
                u32x4 w; w.x = cvt_fp8x4(a0[0], a0[1], a0[2], a0[3]); w.y = cvt_fp8x4(a1[0], a1[1], a1[2], a1[3]); w.z = cvt_fp8x4(b0[0], b0[1], b0[2], b0[3]); w.w = cvt_fp8x4(b1[0], b1[1], b1[2], b1[3]);
                *(u32x4*)rowp = w; }
    }
};
__device__ __forceinline__ float silu_mul(float g, float u) { return g * __builtin_amdgcn_rcpf(1.f + __builtin_amdgcn_exp2f(-g * LOG2E)) * u; }
struct EpiSwiGLU {
    static constexpr bool PERM = true, PERM16 = false;
    unsigned char* ACT;
    __device__ __forceinline__ void operator()(const f32x4 (&acc)[2][2][4][2], const pg8::Unit& u, int ui, int wr, int wc, int fr, int fq) const {
        const int row0 = u.pm * 256 + wr * 64 + fr, col0 = u.pn * 128 + wc * 32 + 8 * fq; constexpr float is = 1.f / W_GU_SCALE;
#pragma unroll
        for (int ai = 0; ai < 2; ++ai)
#pragma unroll
            for (int m = 0; m < 4; ++m) { const f32x4 g0 = acc[ai][0][m][0] * is, g1 = acc[ai][0][m][1] * is, u0 = acc[ai][1][m][0] * (is * ACT_SCALE), u1 = acc[ai][1][m][1] * (is * ACT_SCALE);
                u32x2 w; w.x = cvt_fp8x4(silu_mul(g0[0], u0[0]), silu_mul(g0[1], u0[1]), silu_mul(g0[2], u0[2]), silu_mul(g0[3], u0[3]));
                w.y = cvt_fp8x4(silu_mul(g1[0], u1[0]), silu_mul(g1[1], u1[1]), silu_mul(g1[2], u1[2]), silu_mul(g1[3], u1[3]));
                *(u32x2*)(ACT + (size_t)(row0 + ai * 128 + m * 16) * DEXP + col0) = w; }
    }
};
struct EpiOutProj {
    static constexpr bool PERM = true, PERM16 = false, TABLE = true;
    const bf16* h1; const float* tab; const LAS float* rsL; bf16* y1; float* stats;
    __device__ __forceinline__ void midscale(f32x4 (&acc)[2][2][4][2], int ui, int wr, int fr) const {
#pragma unroll
        for (int ai = 0; ai < 2; ++ai)
#pragma unroll
            for (int m = 0; m < 4; ++m) { const float ratio = rsL[(ui * 256 + ai * 128 + wr * 64 + m * 16 + fr) * 2];
#pragma unroll
                for (int bj = 0; bj < 2; ++bj)
#pragma unroll
                    for (int n = 0; n < 2; ++n) acc[ai][bj][m][n] = acc[ai][bj][m][n] * ratio; }
    }
    __device__ __forceinline__ void table_issue(LAS unsigned char* lds, const pg8::Unit& u, int wid, int lane) const {
        const int b = (u.pm * 256) >> 11;
#pragma unroll
        for (int j = 0; j < 2; ++j) { const int q = 2 * wid + j;
            __builtin_amdgcn_global_load_lds((const unsigned*)(tab + ((size_t)(b * 4 + (q >> 2)) * 2048 + u.pn * 256 + 64 * (q & 3) + lane)), (LAS unsigned*)(lds + P4TAB_OFF + q * 256), 4, 0, 0); }
    }
    __device__ __forceinline__ void operator()(const f32x4 (&acc)[2][2][4][2], const pg8::Unit& u, int ui, int wr, int wc, int fr, int fq) const {
        const int col0 = u.pn * 256 + wc * 32 + 8 * fq;
        const LAS float* T = (const LAS float*)((const LAS unsigned char*)rsL - RS_OFF + P4TAB_OFF) + wc * 32 + 8 * fq;
        constexpr int P4_D = 5;
        u32x4 xq[P4_D][2];
#define P4_ROW(st) ((size_t)u.pm * 256 + ((st) >> 2) * 128 + wr * 64 + ((st) & 3) * 16 + fr)
#define P4_ISSUE(st) do { const size_t off_ = P4_ROW(st) * DM + col0; _Pragma("unroll") for (int bj = 0; bj < 2; ++bj) xq[(st) % P4_D][bj] = *(const u32x4*)(h1 + off_ + bj * 128); } while (0)
#pragma unroll
        for (int st = 0; st < P4_D; ++st) P4_ISSUE(st);
        asm volatile("" ::: "memory");
#pragma unroll
        for (int st = 0; st < 8; ++st) { const int ai = st >> 2, m = st & 3; const size_t row = P4_ROW(st); const float rb = rsL[(ui * 256 + ai * 128 + wr * 64 + m * 16 + fr) * 2 + 1]; float s = 0.f, q = 0.f;
#pragma unroll
            for (int bj = 0; bj < 2; ++bj) { const size_t off = row * DM + col0 + bj * 128; const u32x4 xw = xq[st % P4_D][bj];
                f32x4 v[2];
#pragma unroll
                for (int n = 0; n < 2; ++n) { const LAS float* tp = T + bj * 128 + n * 4;
                    const f32x4 ca = *(const LAS f32x4*)tp, cb = *(const LAS f32x4*)(tp + 256), gv = *(const LAS f32x4*)(tp + 512);
                    const unsigned w0 = n ? xw.z : xw.x, w1 = n ? xw.w : xw.y;
                    const f32x4 x4 = (f32x4){bf_lo(w0), bf_hi(w0), bf_lo(w1), bf_hi(w1)};
                    v[n] = (x4 * ca + cb) + gv * (acc[ai][bj][m][n] * rb); }
                const f32x4 v0 = v[0], v1 = v[1];
                u32x4 w; w.x = cvt_pk_bf16(v0[0], v0[1]); w.y = cvt_pk_bf16(v0[2], v0[3]); w.z = cvt_pk_bf16(v1[0], v1[1]); w.w = cvt_pk_bf16(v1[2], v1[3]); *(u32x4*)(y1 + off) = w;
                s += ((v0[0] + v0[1]) + (v0[2] + v0[3])) + ((v1[0] + v1[1]) + (v1[2] + v1[3]));
                q += ((v0[0] * v0[0] + v0[1] * v0[1]) + (v0[2] * v0[2] + v0[3] * v0[3])) + ((v1[0] * v1[0] + v1[1] * v1[1]) + (v1[2] * v1[2] + v1[3] * v1[3])); }
            s += __shfl_xor(s, 16); s += __shfl_xor(s, 32); q += __shfl_xor(q, 16); q += __shfl_xor(q, 32);
            if (fq == 0) *(f32x2*)(stats + (row * 32 + u.pn * 4 + wc) * 2) = (f32x2){s, q};
            if (st + P4_D < 8) P4_ISSUE(st + P4_D);
            asm volatile("" ::: "memory"); }
#undef P4_ROW
#undef P4_ISSUE
    }
};

struct MoeOrder {
    const LAS int* tst; const LAS int* cnt; const int* list; int nN, G, c, NT; const LAS unsigned* rowtab; const LAS int* rte; int xo;
    __device__ __forceinline__ bool next(int i, pg8::Unit& u) const {
        if (xo) {
            const int x4 = (c >> 5) * 4, U = i * 32 + (c & 31), rt = tst[x4] + U / nN;
            if (rt >= tst[x4 + 4]) return false;
            u.pn = U % nN; u.pm = rt; u.e = rte[rt]; return true; }
        const long L = (long)i * G + c; if (L >= (long)NT * nN) return false;
        const int rt = (int)(L / nN); u.pn = (int)(L % nN); u.pm = rt; u.e = rte[rt]; return true;
    }
    __device__ __forceinline__ unsigned row_off(int ui, int r) const { return rowtab[ui * 256 + r]; }
    __device__ __forceinline__ void fill_rowtab(LAS unsigned* tab, int tid) const {
        pg8::Unit u;
        for (int i = 0; i < 8 && next(i, u); ++i) if (tid < 256) { const int pos = (u.pm - tst[u.e]) * 256 + tid; const int tok = pos < cnt[u.e] ? list[u.e * LCAP + pos] : 0; tab[i * 256 + tid] = (unsigned)tok * (unsigned)DM; }
    }
};

__device__ __forceinline__ f32x16 mfma32(bf16x8 a, bf16x8 b, f32x16 c) { return __builtin_amdgcn_mfma_f32_32x32x16_bf16(a, b, c, 0, 0, 0); }
__device__ __forceinline__ void vt_store(LAS unsigned char* wl, const bf16x8 (&vv)[4], int lane) {
    const int key = lane & 31;
#pragma unroll
    for (int i = 0; i < 4; ++i) { const int d8 = (lane >> 5) + 2 * i;
#pragma unroll
        for (int j = 0; j < 8; ++j) *(LAS short*)(wl + (8 * d8 + j) * 80 + key * 2) = vv[i][j]; }
}
__device__ __forceinline__ void pv_tile(f32x16 (&o)[2], LAS unsigned char* wl, const bf16x8 (&pb)[2], int r32, int hi) {
#pragma unroll
    for (int db = 0; db < 2; ++db)
#pragma unroll
        for (int m = 0; m < 2; ++m) { const bf16x8 vf = *(const LAS bf16x8*)(wl + (32 * db + r32) * 80 + (16 * hi + 8 * m) * 2); o[db] = mfma32(vf, pb[m], o[db]); }
}
__device__ __forceinline__ float o_store(const f32x16 (&o)[2], float sc, bf16* orow, int hi) {
    float ss = 0.f;
#pragma unroll
    for (int db = 0; db < 2; ++db)
#pragma unroll
        for (int g = 0; g < 4; ++g) { const float a = o[db][4 * g] * sc, b = o[db][4 * g + 1] * sc, c = o[db][4 * g + 2] * sc, d = o[db][4 * g + 3] * sc;
            ss += (a * a + b * b) + (c * c + d * d); u32x2 w; w.x = cvt_pk_bf16(a, b); w.y = cvt_pk_bf16(c, d); *(u32x2*)(orow + 32 * db + 8 * g + 4 * hi) = w; }
    return ss;
}

constexpr int IMG_PITCH = 144;
__device__ __forceinline__ const bf16* qh_base(const bf16* QH, int g, int b) { return QH + ((size_t)g * NBATCH + b) * SEQ * 64; }
#define WG_BAR() do { asm volatile("s_waitcnt lgkmcnt(0)" ::: "memory"); __builtin_amdgcn_s_barrier(); asm volatile("" ::: "memory"); } while (0)
typedef short v4i16_t __attribute__((ext_vector_type(4)));
__device__ __forceinline__ v4i16_t vtr(const LAS unsigned char* p) { return __builtin_amdgcn_ds_read_tr16_b64_v4i16((LAS v4i16_t*)p); }
__device__ __forceinline__ f32x16 qk_img(const LAS unsigned char* kimg, int row0, int kap, int hi, const bf16x8 (&qr)[4]) {
    const LAS unsigned char* kp = kimg + (row0 + kap) * IMG_PITCH + hi * 16; f32x16 p = {};
#pragma unroll
    for (int s = 0; s < 4; ++s) p = mfma32(*(const LAS bf16x8*)(kp + 32 * s), qr[s], p);
    return p;
}
__device__ __forceinline__ void pv_img(f32x16 (&o)[2], const LAS unsigned char* vimg, int row0, int vlane, const bf16x8 (&pb)[2]) {
    const LAS unsigned char* vp = vimg + row0 * IMG_PITCH + vlane;
#pragma unroll
    for (int db = 0; db < 2; ++db)
#pragma unroll
        for (int m = 0; m < 2; ++m) { const v4i16_t lo = vtr(vp + (8 * m) * IMG_PITCH + 64 * db), hi4 = vtr(vp + (8 * m + 4) * IMG_PITCH + 64 * db);
            const bf16x8 vf = (bf16x8){lo[0], lo[1], lo[2], lo[3], hi4[0], hi4[1], hi4[2], hi4[3]}; o[db] = mfma32(vf, pb[m], o[db]); }
}
__device__ __forceinline__ void pack_p(bf16x8 (&pb)[2], const float (&a)[16]) {
#pragma unroll
    for (int m = 0; m < 2; ++m) { u32x4 w; w.x = cvt_pk_bf16(a[8 * m], a[8 * m + 1]); w.y = cvt_pk_bf16(a[8 * m + 2], a[8 * m + 3]); w.z = cvt_pk_bf16(a[8 * m + 4], a[8 * m + 5]); w.w = cvt_pk_bf16(a[8 * m + 6], a[8 * m + 7]);
        pb[m] = __builtin_bit_cast(bf16x8, w); }
}
template <int NCH, int NROWS> __device__ __forceinline__ void img_issue(u32x4 (&pre)[NCH], const bf16* kbase, const bf16* vbase, int s0, int tid) {
#pragma unroll
    for (int i = 0; i < NCH; ++i) { const int c = tid + 512 * i, mat = c >= NROWS * 8, rem = c - mat * NROWS * 8, row = rem >> 3, ch = rem & 7;
        if (s0 + row >= 0) pre[i] = *(const u32x4*)((mat ? vbase : kbase) + (long)(s0 + row) * 64 + 8 * ch); }
}
template <int NCH, int NROWS> __device__ __forceinline__ void img_write(const u32x4 (&pre)[NCH], LAS unsigned char* img, int s0, int tid) {
#pragma unroll
    for (int i = 0; i < NCH; ++i) { const int c = tid + 512 * i, mat = c >= NROWS * 8, rem = c - mat * NROWS * 8, row = rem >> 3, ch = rem & 7;
        if (s0 + row >= 0) *(LAS u32x4*)(img + mat * NROWS * IMG_PITCH + row * IMG_PITCH + ch * 16) = pre[i]; }
}

constexpr int SWA_ROWS = 160;
__device__ __forceinline__ void swa_phase(Frame& F) {
    const bf16* QKV = (const bf16*)(F.ws + WS_QKV); bf16* O = (bf16*)(F.ws + WS_O); float* ssq = (float*)(F.ws + WS_SSQ);
    const int tid = F.tid, lane = F.lane, r32 = lane & 31, hi = lane >> 5, g = F.wave;
    const int kap = 16 * ((r32 >> 2) & 1) + (r32 & 3) + 4 * (r32 >> 3);
    const int vlane = (16 * hi + ((lane & 15) >> 2)) * IMG_PITCH + (16 * ((lane >> 4) & 1) + 4 * (lane & 3)) * 2;
    LAS unsigned char* kimg = F.lds; LAS unsigned char* vimg = F.lds + SWA_ROWS * IMG_PITCH;
    LAS float* tbl = (LAS float*)(F.lds + 2 * SWA_ROWS * IMG_PITCH) + g * 192;
    const LAS float* tbq = tbl + (r32 - 16 * hi + 17);
    u32x4 pre[5]; bf16x8 qn[4];
    int u = F.vcu; int hq_tbl = -1; float sink2 = 0.f;
    if (u < 2048) { const int b = u >> 7, kv = (u >> 6) & 1, qt = u & 63;
        img_issue<5, SWA_ROWS>(pre, qh_base(QKV, 16 + kv, b), qh_base(QKV, 18 + kv, b), 32 * (qt - 4), tid);
        const bf16* qp = qh_base(QKV, kv * 8 + g, b) + (size_t)(qt * 32 + r32) * 64 + 8 * hi;
#pragma unroll
        for (int s = 0; s < 4; ++s) qn[s] = *(const bf16x8*)(qp + 16 * s); }
    for (; u < 2048; u += F.G) {
        const int b = u >> 7, kv = (u >> 6) & 1, qt = u & 63, hq = kv * 8 + g; const size_t rowb = (size_t)b * SEQ; const int t0 = qt * 32;
        const int j0 = qt >= 4 ? 0 : 4 - qt;
        bf16x8 qr[4];
#pragma unroll
        for (int s = 0; s < 4; ++s) qr[s] = qn[s];
        if (hq != hq_tbl) {
#pragma unroll
            for (int i = 0; i < 3; ++i) { const int n = lane + 64 * i - 32; int bk = n; float tv = 0.f;
                if (n >= 0 && n < 128) { if (n >= 16) { bk = 16 + (int)(logf((float)n * (1.f / 16.f)) / logf(8.f) * 16.f); bk = bk > 31 ? 31 : bk; } tv = IN_rel_bias[bk * 16 + hq] * LOG2E; }
                tbl[n + 32] = tv; }
            sink2 = IN_sinks[hq] * LOG2E; hq_tbl = hq;
        }
        WG_BAR();
        img_write<5, SWA_ROWS>(pre, kimg, 32 * (qt - 4), tid);
        WG_BAR();
        { const int un = u + F.G; if (un < 2048) { const int bn = un >> 7, kvn = (un >> 6) & 1, qtn = un & 63;
            img_issue<5, SWA_ROWS>(pre, qh_base(QKV, 16 + kvn, bn), qh_base(QKV, 18 + kvn, bn), 32 * (qtn - 4), tid);
            const bf16* qp = qh_base(QKV, kvn * 8 + g, bn) + (size_t)(qtn * 32 + r32) * 64 + 8 * hi;
#pragma unroll
            for (int s = 0; s < 4; ++s) qn[s] = *(const bf16x8*)(qp + 16 * s); } }
        f32x16 st[5]; float mx = sink2;
#pragma unroll
        for (int j = 0; j < 5; ++j) {
            if (j < j0) {
#pragma unroll
                for (int r = 0; r < 16; ++r) st[j][r] = -1e30f;
            } else {
                f32x16 p;
#pragma unroll
                for (int r = 0; r < 16; ++r) p[r] = tbq[32 * (4 - j) + 15 - r];
                { const LAS unsigned char* kp = kimg + (32 * j + kap) * IMG_PITCH + hi * 16;
#pragma unroll
                  for (int s = 0; s < 4; ++s) p = mfma32(*(const LAS bf16x8*)(kp + 32 * s), qr[s], p); }
                if (j == 0) {
#pragma unroll
                    for (int r = 0; r < 16; ++r) p[r] = (r >= r32 - 16 * hi + 1) ? p[r] : -1e30f;
                }
                if (j == 4) {
#pragma unroll
                    for (int r = 0; r < 16; ++r) p[r] = (r <= r32 - 16 * hi) ? p[r] : -1e30f;
                }
#pragma unroll
                for (int r = 0; r < 16; ++r) mx = fmaxf(mx, p[r]);
                st[j] = p;
            } }
        mx = fmaxf(mx, __shfl_xor(mx, 32));
        float den = 0.f;
#pragma unroll
        for (int j = 0; j < 5; ++j)
#pragma unroll
            for (int r = 0; r < 16; ++r) { const float e = __builtin_amdgcn_exp2f(st[j][r] - mx); st[j][r] = e; den += e; }
        den += __shfl_xor(den, 32); den += __builtin_amdgcn_exp2f(sink2 - mx);
        f32x16 o[2]; o[0] = (f32x16){}; o[1] = (f32x16){};
#pragma unroll
        for (int j = 0; j < 5; ++j) {
            if (j >= j0) { bf16x8 pb[2]; float a[16];
#pragma unroll
                for (int r = 0; r < 16; ++r) a[r] = st[j][r];
                pack_p(pb, a); pv_img(o, vimg, 32 * j, vlane, pb); } }
        float ss = o_store(o, 1.f / den, O + (rowb + t0 + r32) * DM + 64 * hq, hi);
        ss += __shfl_xor(ss, 32);
        if (hi == 0) ssq[(rowb + t0 + r32) * 32 + hq] = ss;
    }
    WG_BAR();
}

constexpr int SB_ROWS = 352, SB_BELOW = 3;
constexpr float SB_CUT = 5.421010862427522e-20f;
__device__ __forceinline__ void sb_tile_math(f32x16 p, bool diag, int r32, int hi, float& C, bf16x8 (&pb)[2]) {
    float rr[16], be[16];
#pragma unroll
    for (int r = 0; r < 16; ++r) { const float e = __builtin_amdgcn_exp2f(p[r]); const float q = __builtin_amdgcn_rcpf(1.f + e); rr[r] = q; be[r] = 1.f - q; }
    if (diag) {
#pragma unroll
        for (int r = 0; r < 16; ++r) if (16 * hi + r >= r32) { rr[r] = 1.f; be[r] = 0.f; }
    }
    float run = 1.f, a[16];
#pragma unroll
    for (int r = 15; r >= 0; --r) { a[r] = be[r] * run; run *= rr[r]; }
    const float other = __shfl_xor(run, 32);
    const float base = hi ? C : C * other;
    C = C * run * other; C = C < SB_CUT ? 0.f : C;
#pragma unroll
    for (int r = 0; r < 16; ++r) a[r] *= base;
    pack_p(pb, a);
}
__device__ __forceinline__ void sb_tail(f32x16 (&o)[2], float& C, int kt, const bf16* KH, const bf16* VH, const bf16x8 (&qr)[4], LAS unsigned char* wl, int lane) {
    const int r32 = lane & 31, hi = lane >> 5; const int kap = 16 * ((r32 >> 2) & 1) + (r32 & 3) + 4 * (r32 >> 3);
    for (; kt >= 0; --kt) {
        const bf16* kp = KH + (size_t)(kt * 32 + kap) * 64 + 8 * hi; bf16x8 kf[4];
#pragma unroll
        for (int s = 0; s < 4; ++s) kf[s] = *(const bf16x8*)(kp + 16 * s);
        bf16x8 vv[4];
        { const bf16* vp = VH + (size_t)(kt * 32 + (lane & 31)) * 64 + 8 * (lane >> 5);
#pragma unroll
          for (int i = 0; i < 4; ++i) vv[i] = *(const bf16x8*)(vp + 16 * i); }
        f32x16 p = {};
#pragma unroll
        for (int s = 0; s < 4; ++s) p = mfma32(kf[s], qr[s], p);
        bf16x8 pb[2]; sb_tile_math(p, false, r32, hi, C, pb);
        vt_store(wl, vv, lane); LDS_WAIT();
        pv_tile(o, wl, pb, r32, hi); LDS_WAIT();
        if (__all(C == 0.f)) break;
    }
}
__device__ __forceinline__ void sb_phase(Frame& F) {
    const bf16* QKV = (const bf16*)(F.ws + WS_QKV); bf16* O = (bf16*)(F.ws + WS_O); float* ssq = (float*)(F.ws + WS_SSQ);
    const int tid = F.tid, lane = F.lane, r32 = lane & 31, hi = lane >> 5, w = F.wave;
    const int kap = 16 * ((r32 >> 2) & 1) + (r32 & 3) + 4 * (r32 >> 3);
    const int vlane = (16 * hi + ((lane & 15) >> 2)) * IMG_PITCH + (16 * ((lane >> 4) & 1) + 4 * (lane & 3)) * 2;
    LAS unsigned char* kimg = F.lds; LAS unsigned char* vimg = F.lds + SB_ROWS * IMG_PITCH;
    u32x4 pre[11]; bf16x8 qn[4];
    int u = F.vcu;
    if (u < 2048) { const int b = u >> 7, h = (u >> 3) & 15, qg = u & 7;
        img_issue<11, SB_ROWS>(pre, qh_base(QKV, 36 + h, b), qh_base(QKV, 52 + h, b), 32 * (8 * qg - SB_BELOW), tid);
        const bf16* qp = qh_base(QKV, 20 + h, b) + (size_t)((8 * qg + w) * 32 + r32) * 64 + 8 * hi;
#pragma unroll
        for (int s = 0; s < 4; ++s) qn[s] = *(const bf16x8*)(qp + 16 * s); }
    for (; u < 2048; u += F.G) {
        const int b = u >> 7, h = (u >> 3) & 15, qg = u & 7, qt = 8 * qg + w; const size_t rowb = (size_t)b * SEQ; const int t0 = qt * 32;
        const int tb = 8 * qg - SB_BELOW;
        bf16x8 qr[4];
#pragma unroll
        for (int s = 0; s < 4; ++s) qr[s] = qn[s];
        WG_BAR();
        img_write<11, SB_ROWS>(pre, kimg, 32 * tb, tid);
        WG_BAR();
        { const int un = u + F.G; if (un < 2048) { const int bn = un >> 7, hn = (un >> 3) & 15, qgn = un & 7;
            img_issue<11, SB_ROWS>(pre, qh_base(QKV, 36 + hn, bn), qh_base(QKV, 52 + hn, bn), 32 * (8 * qgn - SB_BELOW), tid);
            const bf16* qp = qh_base(QKV, 20 + hn, bn) + (size_t)((8 * qgn + w) * 32 + r32) * 64 + 8 * hi;
#pragma unroll
            for (int s = 0; s < 4; ++s) qn[s] = *(const bf16x8*)(qp + 16 * s); } }
        f32x16 o[2]; o[0] = (f32x16){}; o[1] = (f32x16){};
        float C = 1.f;
        const int kt_lo = tb > 0 ? tb : 0; int kt = qt;
        for (; kt >= kt_lo; --kt) {
            const f32x16 p = qk_img(kimg, 32 * (kt - tb), kap, hi, qr);
            bf16x8 pb[2]; sb_tile_math(p, kt == qt, r32, hi, C, pb);
            pv_img(o, vimg, 32 * (kt - tb), vlane, pb);
            if (__all(C == 0.f)) { kt = -1; break; }
        }
        WG_BAR();
        if (kt >= 0) sb_tail(o, C, kt, qh_base(QKV, 36 + h, b), qh_base(QKV, 52 + h, b), qr, F.lds + w * 8192, lane);
        float ss = o_store(o, 1.f, O + (rowb + t0 + r32) * DM + 1024 + 64 * h, hi);
        ss += __shfl_xor(ss, 32);
        if (hi == 0) ssq[(rowb + t0 + r32) * 32 + 16 + h] = ss;
    }
    WG_BAR();
}

__device__ __forceinline__ void p3_attention(Frame& F) {
    swa_phase(F);
    sb_phase(F);
}

__device__ __forceinline__ void p5_router(Frame& F) {
    const float* mod = (const float*)(F.ws + WS_MOD); const float* stats = (const float*)(F.ws + WS_STATS); bf16* H = (bf16*)(F.ws + WS_H);
    const bf16* wrh = (const bf16*)(F.ws + WS_WR); const bf16* wrl = wrh + 48 * 2048;
    int* pair_e = (int*)(F.ws + WS_PAIR); int* pair_pos = pair_e + TOK * 2; float* pair_g = (float*)(pair_pos + TOK * 2); float* rowstat = pair_g + TOK * 2; int* list = (int*)(F.ws + WS_LIST);
    LAS float* A2 = (LAS float*)F.lds; LAS float* B2 = A2 + 2048;
    LAS unsigned char* wch = F.lds + 16384;
    LAS float* lg = (LAS float*)(F.lds + 16384 + 2 * 48 * 528 + 512) + F.wave * 768;
    LAS int* wcnt = (LAS int*)(F.lds + 16384 + 2 * 48 * 528 + 512 + 8 * 3072); LAS int* wbase = wcnt + 32;
    LAS int* rowe = wbase + 32; LAS float* rowg = (LAS float*)(rowe + 256); LAS int* rowrank = (LAS int*)(rowg + 256);
    const int lane = F.lane, row16 = lane & 15, kq = lane >> 4;
    for (int blk = F.vcu; blk < 256; blk += F.G) {
        const int b = blk >> 4;
        for (int k = F.tid; k < 2048; k += 512) { const float s2 = 1.f + mod[b * 12288 + 8192 + k]; A2[k] = IN_ln1_g[k] * s2; B2[k] = IN_ln1_b[k] * s2 + mod[b * 12288 + 6144 + k]; }
        if (F.tid < 32) wcnt[F.tid] = 0;
        __syncthreads();
        const size_t row = (size_t)blk * 128 + F.wave * 16 + row16;
        float mean, rstd;
        { float s = 0.f, q = 0.f; const f32x2* sp = (const f32x2*)(stats + row * 64) + kq * 8;
#pragma unroll
          for (int i = 0; i < 8; ++i) { const f32x2 v = sp[i]; s += v.x; q += v.y; }
          s += __shfl_xor(s, 16); s += __shfl_xor(s, 32); q += __shfl_xor(q, 16); q += __shfl_xor(q, 32);
          mean = s * (1.f / DM); const float var = fmaxf(q * (1.f / DM) - mean * mean, 0.f); rstd = 1.f / sqrtf(var + LN_EPS);
          if (kq == 0) *(f32x2*)(rowstat + row * 2) = (f32x2){mean, rstd}; }
        f32x4 acc[3]; acc[0] = (f32x4){0.f, 0.f, 0.f, 0.f}; acc[1] = acc[0]; acc[2] = acc[0];
        const bf16* yrow = (const bf16*)(F.ws + WS_Y1) + row * DM + 8 * kq; unsigned char* hrow = (unsigned char*)H + row * DM + 8 * kq;
        u32x4 wpre[6];
#define P5_WISSUE(kc) do { _Pragma("unroll") for (int i = 0; i < 6; ++i) { const int c = F.tid + 512 * i, mat = c >= 1536, rem = c - mat * 1536, wrow = rem >> 5, ch = rem & 31; \
            wpre[i] = *(const u32x4*)((mat ? wrl : wrh) + (size_t)wrow * 2048 + (kc) + 8 * ch); } } while (0)
#define P5_WWRITE() do { _Pragma("unroll") for (int i = 0; i < 6; ++i) { const int c = F.tid + 512 * i, mat = c >= 1536, rem = c - mat * 1536, wrow = rem >> 5, ch = rem & 31; \
            *(LAS u32x4*)(wch + mat * (48 * 528) + wrow * 528 + ch * 16) = wpre[i]; } } while (0)
        P5_WISSUE(0);
        const LAS unsigned char* bfrag = wch + row16 * 528 + kq * 16;
        u32x4 yc[8], yn[8];
#pragma unroll
        for (int st = 0; st < 8; ++st) yn[st] = *(const u32x4*)(yrow + 32 * st);
        for (int kc = 0; kc < 2048; kc += 256) {
            WG_BAR();
            P5_WWRITE();
            WG_BAR();
#pragma unroll
            for (int st = 0; st < 8; ++st) yc[st] = yn[st];
            if (kc + 256 < 2048) { P5_WISSUE(kc + 256);
#pragma unroll
                for (int st = 0; st < 8; ++st) yn[st] = *(const u32x4*)(yrow + kc + 256 + 32 * st); }
#pragma unroll
            for (int st = 0; st < 8; ++st) { const int k0 = kc + 32 * st;
                const u32x4 yw = yc[st]; const f32x4 y0 = (f32x4){bf_lo(yw.x), bf_hi(yw.x), bf_lo(yw.y), bf_hi(yw.y)}, y1v = (f32x4){bf_lo(yw.z), bf_hi(yw.z), bf_lo(yw.w), bf_hi(yw.w)};
                const f32x4 a0 = *(const LAS f32x4*)(A2 + k0 + 8 * kq), a1 = *(const LAS f32x4*)(A2 + k0 + 8 * kq + 4), b0 = *(const LAS f32x4*)(B2 + k0 + 8 * kq), b1 = *(const LAS f32x4*)(B2 + k0 + 8 * kq + 4);
                const f32x4 h0 = (y0 - mean) * rstd * a0 + b0, h1 = (y1v - mean) * rstd * a1 + b1;
                u32x4 ph; ph.x = cvt_pk_bf16(h0[0], h0[1]); ph.y = cvt_pk_bf16(h0[2], h0[3]); ph.z = cvt_pk_bf16(h1[0], h1[1]); ph.w = cvt_pk_bf16(h1[2], h1[3]);
                { u32x2 h8; h8.x = cvt_fp8x4(h0[0], h0[1], h0[2], h0[3]); h8.y = cvt_fp8x4(h1[0], h1[1], h1[2], h1[3]); *(u32x2*)(hrow + k0) = h8; }
                u32x4 pl; pl.x = cvt_pk_bf16(h0[0] - bf_lo(ph.x), h0[1] - bf_hi(ph.x)); pl.y = cvt_pk_bf16(h0[2] - bf_lo(ph.y), h0[3] - bf_hi(ph.y));
                pl.z = cvt_pk_bf16(h1[0] - bf_lo(ph.z), h1[1] - bf_hi(ph.z)); pl.w = cvt_pk_bf16(h1[2] - bf_lo(ph.w), h1[3] - bf_hi(ph.w));
                const bf16x8 ah = __builtin_bit_cast(bf16x8, ph), al = __builtin_bit_cast(bf16x8, pl);
                bf16x8 wh[3], wl2[3];
#pragma unroll
                for (int cg = 0; cg < 3; ++cg) { wh[cg] = *(const LAS bf16x8*)(bfrag + cg * 16 * 528 + st * 64); wl2[cg] = *(const LAS bf16x8*)(bfrag + 48 * 528 + cg * 16 * 528 + st * 64); }
#pragma unroll
                for (int cg = 0; cg < 3; ++cg) acc[cg] = __builtin_amdgcn_mfma_f32_16x16x32_bf16(ah, wh[cg], acc[cg], 0, 0, 0);
#pragma unroll
                for (int cg = 0; cg < 3; ++cg) acc[cg] = __builtin_amdgcn_mfma_f32_16x16x32_bf16(al, wh[cg], acc[cg], 0, 0, 0);
#pragma unroll
                for (int cg = 0; cg < 3; ++cg) acc[cg] = __builtin_amdgcn_mfma_f32_16x16x32_bf16(ah, wl2[cg], acc[cg], 0, 0, 0); }
        }
#undef P5_WISSUE
#undef P5_WWRITE
#pragma unroll
        for (int cg = 0; cg < 3; ++cg)
#pragma unroll
            for (int i = 0; i < 4; ++i) lg[(4 * kq + i) * 48 + 16 * cg + row16] = acc[cg][i];
        LDS_WAIT();
        if (lane < 16) {
            const LAS float* l = lg + lane * 48; float gl[4];
#pragma unroll
            for (int j = 0; j < 4; ++j) gl[j] = l[j] + IN_b_grp[j];
            int gs = 0; float gm = gl[0];
#pragma unroll
            for (int j = 1; j < 4; ++j) if (gl[j] > gm) { gm = gl[j]; gs = j; }
            float gsum = 0.f;
#pragma unroll
            for (int j = 0; j < 4; ++j) gsum += expf(gl[j] - gm);
            const float pg = 1.f / gsum;
            float v0 = -INFINITY, v1 = -INFINITY; int i0 = 0, i1 = 0;
            for (int j = 0; j < 8; ++j) { const float v = l[4 + 8 * gs + j] + IN_b_rtr[8 * gs + j];
                if (v > v0) { v1 = v0; i1 = i0; v0 = v; i0 = j; } else if (v > v1) { v1 = v; i1 = j; } }
            const float e1 = expf(v1 - v0), inv = 1.f / (1.f + e1);
            const int lr = F.wave * 16 + lane;
            rowe[2 * lr] = 8 * gs + i0; rowe[2 * lr + 1] = 8 * gs + i1; rowg[2 * lr] = pg * inv; rowg[2 * lr + 1] = pg * e1 * inv;
        }
        __syncthreads();
        if (F.tid < 256) rowrank[F.tid] = __hip_atomic_fetch_add(wcnt + rowe[F.tid], 1, __ATOMIC_RELAXED, __HIP_MEMORY_SCOPE_WORKGROUP);
        __syncthreads();
        if (F.tid < 32) wbase[F.tid] = (int)__hip_atomic_fetch_add(F.ctl + CW_CNT + 64 * F.tid, (unsigned)wcnt[F.tid], __ATOMIC_RELAXED, __HIP_MEMORY_SCOPE_AGENT);
        __syncthreads();
        if (F.tid < 256) { const int e = rowe[F.tid], pos = wbase[e] + rowrank[F.tid]; const int tok = blk * 128 + (F.tid >> 1); const size_t pi = (size_t)tok * 2 + (F.tid & 1);
            pair_e[pi] = e; pair_pos[pi] = pos; pair_g[pi] = rowg[F.tid]; list[(size_t)e * LCAP + pos] = tok; }
        __syncthreads();
    }
}

__device__ __forceinline__ int moe_tables(Frame& F) {
    LAS int* tst = (LAS int*)(F.lds + TBL_OFF); LAS int* cnt = tst + 40;
    if (F.tid < 32) cnt[F.tid] = (int)__hip_atomic_load(F.ctl + CW_CNT + 64 * F.tid, __ATOMIC_RELAXED, __HIP_MEMORY_SCOPE_AGENT);
    __syncthreads();
    if (F.tid == 0) { int s = 0; for (int e = 0; e < 32; ++e) { tst[e] = s; s += (cnt[e] + 255) >> 8; } tst[32] = s; }
    __syncthreads();
    if (F.tid < MAXTILES) { int e = 0; while (e < 31 && tst[e + 1] <= F.tid) ++e; ((LAS int*)(F.lds + RTE_OFF))[F.tid] = e; }
    __syncthreads();
    return tst[32];
}

__device__ __forceinline__ void p8_final(Frame& F) {
    const float* mod = (const float*)(F.ws + WS_MOD); const float* stats = (const float*)(F.ws + WS_STATS); const unsigned char* YS = F.ws + WS_YS;
    const int* pair_e = (const int*)(F.ws + WS_PAIR); const int* pair_pos = pair_e + TOK * 2; const float* pair_g = (const float*)(pair_pos + TOK * 2); const float* rowstat = pair_g + TOK * 2;
    const LAS int* tst = (const LAS int*)(F.lds + TBL_OFF);
    LAS float* G1 = (LAS float*)F.lds; LAS float* B1 = G1 + 2048; LAS float* GT = B1 + 2048; LAS float* G2 = GT + 2048; LAS float* Bv2 = G2 + 2048;
    for (int blk = F.vcu; blk < 256; blk += F.G) {
        const int b = blk >> 4;
        for (int k = F.tid; k < 2048; k += 512) { G1[k] = IN_ln1_g[k]; B1[k] = IN_ln1_b[k]; GT[k] = 1.f + mod[b * 12288 + 10240 + k]; G2[k] = IN_ln2_g[k]; Bv2[k] = IN_ln2_b[k]; }
        __syncthreads();
        for (int r = F.wave; r < 128; r += 16) {
            float mean[2], rstd[2], g0[2], g1[2]; size_t s0[2], s1[2]; f32x4 v[2][8]; float sum[2];
#pragma unroll
            for (int q = 0; q < 2; ++q) { const size_t row = (size_t)blk * 128 + r + 8 * q;
                mean[q] = rowstat[row * 2]; rstd[q] = rowstat[row * 2 + 1];
                const int e0 = pair_e[row * 2], e1 = pair_e[row * 2 + 1]; g0[q] = pair_g[row * 2] * (1.f / YS_SCALE); g1[q] = pair_g[row * 2 + 1] * (1.f / YS_SCALE);
                s0[q] = (size_t)tst[e0] * 256 + pair_pos[row * 2]; s1[q] = (size_t)tst[e1] * 256 + pair_pos[row * 2 + 1]; }
            u32x2 yw[2][8]; unsigned ya[2][8], yb[2][8];
#pragma unroll
            for (int q = 0; q < 2; ++q) { const size_t row = (size_t)blk * 128 + r + 8 * q;
#pragma unroll
                for (int j = 0; j < 8; ++j) { const int col = 4 * F.lane + 256 * j; yw[q][j] = *(const u32x2*)((const bf16*)(F.ws + WS_Y1) + row * DM + col);
                    ya[q][j] = *(const unsigned*)(YS + s0[q] * DM + col); yb[q][j] = *(const unsigned*)(YS + s1[q] * DM + col); } }
            asm volatile("" ::: "memory");
#pragma unroll
            for (int q = 0; q < 2; ++q) { sum[q] = 0.f;
#pragma unroll
                for (int j = 0; j < 8; ++j) { const int col = 4 * F.lane + 256 * j; const f32x4 y = (f32x4){bf_lo(yw[q][j].x), bf_hi(yw[q][j].x), bf_lo(yw[q][j].y), bf_hi(yw[q][j].y)};
                    const f32x2 al = __builtin_amdgcn_cvt_pk_f32_fp8((int)ya[q][j], false), ah = __builtin_amdgcn_cvt_pk_f32_fp8((int)ya[q][j], true), bl = __builtin_amdgcn_cvt_pk_f32_fp8((int)yb[q][j], false), bh = __builtin_amdgcn_cvt_pk_f32_fp8((int)yb[q][j], true);
                    const f32x4 fa = (f32x4){al.x, al.y, ah.x, ah.y}, fb = (f32x4){bl.x, bl.y, bh.x, bh.y};
                    const f32x4 x1 = (y - mean[q]) * rstd[q] * *(const LAS f32x4*)(G1 + col) + *(const LAS f32x4*)(B1 + col);
                    v[q][j] = x1 * ALPHA_DN + *(const LAS f32x4*)(GT + col) * (fa * g0[q] + fb * g1[q]); sum[q] += (v[q][j][0] + v[q][j][1]) + (v[q][j][2] + v[q][j][3]);
                    if (j & 1) asm volatile("" ::: "memory"); } }
            float m2[2], sq[2], r2[2];
#pragma unroll
            for (int q = 0; q < 2; ++q) { m2[q] = wave_sum(sum[q]) * (1.f / DM); sq[q] = 0.f;
#pragma unroll
                for (int j = 0; j < 8; ++j) { v[q][j] = v[q][j] - m2[q]; sq[q] += (v[q][j][0] * v[q][j][0] + v[q][j][1] * v[q][j][1]) + (v[q][j][2] * v[q][j][2] + v[q][j][3] * v[q][j][3]); } }
#pragma unroll
            for (int q = 0; q < 2; ++q) { const size_t row = (size_t)blk * 128 + r + 8 * q; r2[q] = 1.f / sqrtf(wave_sum(sq[q]) * (1.f / DM) + LN_EPS);
#pragma unroll
                for (int j = 0; j < 8; ++j) { const int col = 4 * F.lane + 256 * j; __builtin_nontemporal_store(v[q][j] * r2[q] * *(const LAS f32x4*)(G2 + col) + *(const LAS f32x4*)(Bv2 + col), (f32x4*)(F.out + row * DM + col)); } } }
        __syncthreads();
    }
}

struct Args { const float* in[21]; float* out; unsigned char* ws; };
__global__ void __launch_bounds__(512, 2) hybrid_fwd(Args args) {
    extern __shared__ __attribute__((aligned(16))) unsigned char lds[];
    Frame F;
    F.lds = (LAS unsigned char*)lds;
    F.tid = threadIdx.x; F.lane = F.tid & 63; F.wave = __builtin_amdgcn_readfirstlane(F.tid >> 6);
    F.G = gridDim.x; { const int bx = blockIdx.x; F.vcu = (F.G % 8 == 0) ? (bx % 8) * (F.G / 8) + bx / 8 : bx; }
    F.ws = args.ws; F.out = args.out; F.ctl = (unsigned*)(args.ws + WS_CTL);
    F.in = args.in;
    volatile LAS unsigned* MISC = (volatile LAS unsigned*)(F.lds + MISC_OFF);
    if (F.tid < 32) MISC[F.tid] = 0u;
    __syncthreads();
    XcdBarrier bar = xcd_barrier_post(F.ctl + CW_BAR, MISC + 8);

#ifndef PHMASK
#define PHMASK 0x1ff
#endif
#ifndef REPMASK
#define REPMASK 0
#endif
#define REFRESH() do { int t_ = threadIdx.x; asm volatile("" : "+v"(t_)); F.tid = t_; F.lane = t_ & 63; } while (0)
#define PH(n) if constexpr (((PHMASK) >> (n)) & 1) _Pragma("nounroll") for (int rep_ = 0; rep_ < 1 + (((REPMASK) >> (n)) & 1); ++rep_, __syncthreads())
    REFRESH();
    PH(0) p0_prologue(F);
    xcd_barrier(bar);
    REFRESH();
    PH(1) p1_modulate(F);
    xcd_barrier(bar);
    REFRESH();
    PH(2) { pg8::Gemm g{(const bf16*)(F.ws + WS_H), (const bf16*)(F.ws + WS_WIN), DM, 0}; pg8::StaticOrder S; S.init(TOK, QKVD, F.G, (int)blockIdx.x);
      EpiStoreBf16 E{(bf16*)(F.ws + WS_QKV), QKVD, 1.f};
      cvt8_deferred2(F, 0); __syncthreads();
      pg8::gemm_phase<EpiStoreBf16, pg8::StaticOrder, false, false>(F.lds, g, S, E);
      cvt8_deferred2(F, 1); }
    xcd_barrier(bar);
    REFRESH();
    PH(3) p3_attention(F);
    xcd_barrier(bar);
    REFRESH();
    PH(4) { pg8::Gemm g{(const bf16*)(F.ws + WS_O), (const bf16*)(F.ws + WS_WOUT), DM, 0}; pg8::StaticOrder S; S.init(TOK, DM, F.G, (int)blockIdx.x);
      cvt8_deferred4(F);
      LAS float* rsL = (LAS float*)(F.lds + RS_OFF); const float* ssq = (const float*)(F.ws + WS_SSQ);
      { pg8::Unit u;
        for (int i = 0; i < 4 && S.next(i, u); ++i) if (F.tid < 256) { const f32x4* sp = (const f32x4*)(ssq + (size_t)(u.pm * 256 + F.tid) * 32); float sa = 0.f, sb = 0.f;
#pragma unroll
            for (int j = 0; j < 4; ++j) { const f32x4 va = sp[j], vb = sp[4 + j]; sa += (va[0] + va[1]) + (va[2] + va[3]); sb += (vb[0] + vb[1]) + (vb[2] + vb[3]); }
            const float ra = 1.f / sqrtf(sa * (1.f / 1024.f) + LN_EPS), rb = 1.f / sqrtf(sb * (1.f / 1024.f) + LN_EPS);
            rsL[(i * 256 + F.tid) * 2] = ra / rb; rsL[(i * 256 + F.tid) * 2 + 1] = rb; } }
      __syncthreads();
      EpiOutProj E{(const bf16*)(F.ws + WS_H), (const float*)(F.ws + WS_P4TAB), rsL, (bf16*)(F.ws + WS_Y1), (float*)(F.ws + WS_STATS)};
      pg8::gemm_phase<EpiOutProj, pg8::StaticOrder, false, true>(F.lds, g, S, E); }
    xcd_barrier(bar);
    REFRESH();
    PH(5) p5_router(F);
    xcd_barrier(bar);
    REFRESH();
    const int NT = moe_tables(F);
    REFRESH();
    PH(6) { pg8::Gemm g{(const bf16*)(F.ws + WS_H), (const bf16*)(F.ws + WS_WGU), DM / 2, (size_t)1024 * DM};
      MoeOrder S{(const LAS int*)(F.lds + TBL_OFF), (const LAS int*)(F.lds + TBL_OFF) + 40, (const int*)(F.ws + WS_LIST), 4, F.G, F.vcu, NT, (const LAS unsigned*)(F.lds + RS_OFF), (const LAS int*)(F.lds + RTE_OFF), 0};
      S.fill_rowtab((LAS unsigned*)(F.lds + RS_OFF), F.tid); __syncthreads();
      EpiSwiGLU E{F.ws + WS_ACT};
      pg8::gemm_phase<EpiSwiGLU, MoeOrder, true, false, true>(F.lds, g, S, E);
      cvt8_deferred6(F, NT * 4); }
    xcd_barrier(bar);
    REFRESH();
    PH(7) { pg8::Gemm g{(const bf16*)(F.ws + WS_ACT), (const bf16*)(F.ws + WS_WDN), DEXP / 2, (size_t)DM * DEXP};
      MoeOrder S{(const LAS int*)(F.lds + TBL_OFF), (const LAS int*)(F.lds + TBL_OFF) + 40, (const int*)(F.ws + WS_LIST), 8, F.G, F.vcu, NT, (const LAS unsigned*)(F.lds + RS_OFF), (const LAS int*)(F.lds + RTE_OFF), 0};
      EpiStoreFp8 E{F.ws + WS_YS, DM, YS_SCALE / (ACT_SCALE * W_DN_SCALE)};
      pg8::gemm_phase<EpiStoreFp8, MoeOrder, false, false, true>(F.lds, g, S, E); }
    xcd_barrier(bar);
    REFRESH();
    PH(8) p8_final(F);
}

extern "C" void kernel_launch(void* const* d_in, const int* in_sizes, int n_in, void* d_out, int out_size, void* d_ws, size_t ws_size, hipStream_t stream) {
    static int grid = 0;
    if (grid == 0) {
        if (n_in != 21 || out_size != TOK * DM || ws_size < WS_END) { fprintf(stderr, "kernel_launch: unexpected problem shape (n_in %d, out %d, ws %zu)\n", n_in, out_size, ws_size); grid = -1; return; }
        int dev = 0, cus = 0, per_cu = 0;
        if (hipGetDevice(&dev) != hipSuccess || hipDeviceGetAttribute(&cus, hipDeviceAttributeMultiprocessorCount, dev) != hipSuccess) { grid = -1; return; }
        if (hipFuncSetAttribute((const void*)hybrid_fwd, hipFuncAttributeMaxDynamicSharedMemorySize, LDS_BYTES) != hipSuccess) { fprintf(stderr, "kernel_launch: hipFuncSetAttribute failed\n"); grid = -1; return; }
        if (hipOccupancyMaxActiveBlocksPerMultiprocessor(&per_cu, (const void*)hybrid_fwd, 512, LDS_BYTES) != hipSuccess || per_cu < 1) { fprintf(stderr, "kernel_launch: occupancy query reports %d\n", per_cu); }
        (void)hipGetLastError();
        grid = cus;
    }
    if (grid < 0) return;
    if (hipMemsetAsync((char*)d_ws + WS_CTL, 0, CTL_ZERO_BYTES, stream) != hipSuccess) return;
    Args a{};
    for (int i = 0; i < 21; ++i) a.in[i] = (const float*)d_in[i];
    a.out = (float*)d_out; a.ws = (unsigned char*)d_ws;
    hipLaunchKernelGGL(hybrid_fwd, dim3(grid), dim3(512), LDS_BYTES, stream, a);
}
```

```cpp
#include <hip/hip_runtime.h>
#include <cstdio>
#include <cstdint>

constexpr int TOK = 32768, DM = 2048, SEQ = 2048, NBATCH = 16, QKVD = 4352;
constexpr int NEXP = 32, DEXP = 512, LCAP = 32768;
constexpr int MAXTILES = 288, SLOTS = MAXTILES * 256;
constexpr float ALPHA_DN = 1.189207115002721f;
constexpr float LN_EPS = 1e-5f;
constexpr float LOG2E = 1.4426950408889634f;
constexpr float W_GU_SCALE = 64.f, W_DN_SCALE = 32.f, ACT_SCALE = 8.f, YS_SCALE = 16.f;
constexpr float QSCALE = 0.125f * 1.4426950408889634f;
constexpr int COL_KA = 1024, COL_VA = 1152, COL_QB = 1280, COL_KB = 2304, COL_VB = 3328;

constexpr size_t MiB = 1u << 20;
constexpr size_t WS_CTL = 0, CTL_ZERO_BYTES = 96 * 1024;
constexpr size_t WS_MOD = 1 * MiB;
constexpr size_t WS_SSQ = 894 * MiB;
constexpr size_t WS_P4TAB = 2 * MiB;
constexpr size_t WS_PAIR = 3 * MiB;
constexpr size_t WS_WR = 4 * MiB;
constexpr size_t WS_STATS = 8 * MiB;
constexpr size_t WS_LIST = 16 * MiB;
constexpr size_t WS_WIN = 20 * MiB;
constexpr size_t WS_WOUT = 38 * MiB;
constexpr size_t WS_WGU = 46 * MiB;
constexpr size_t WS_WDN = 174 * MiB;
constexpr size_t WS_H = 238 * MiB;
constexpr size_t WS_QKV = 366 * MiB;
constexpr size_t WS_O = 638 * MiB;
constexpr size_t WS_ACT = 366 * MiB;
constexpr size_t WS_YS = 438 * MiB;
constexpr size_t WS_Y1 = 766 * MiB;
constexpr size_t WS_END = 898 * MiB;
static_assert(WS_WIN + (size_t)QKVD * DM * 2 <= WS_WOUT && WS_QKV + (size_t)TOK * QKVD * 2 <= WS_O && WS_ACT + (size_t)SLOTS * DEXP * 2 <= WS_YS && WS_YS + (size_t)SLOTS * DM * 2 <= WS_Y1 && WS_Y1 + (size_t)TOK * DM * 2 <= WS_SSQ && WS_SSQ + (size_t)TOK * 32 * 4 <= WS_END, "d_ws map");
constexpr int CW_BAR = 4096;
constexpr int CW_CNT = 16384;
static_assert((CW_CNT + 64 * 32) * 4 <= (int)CTL_ZERO_BYTES && (CW_BAR + 3456) * 4 <= CW_CNT * 4, "control words inside the per-call memset");

constexpr int RING_BYTES = 131072;
constexpr int MISC_OFF = RING_BYTES + 320;
constexpr int TBL_OFF = RING_BYTES + 1024;
constexpr int RS_OFF = RING_BYTES + 2048;
constexpr int RTE_OFF = RS_OFF + 8192;
constexpr int P4TAB_OFF = 142464;
constexpr int LDS_BYTES = 147456;
static_assert(RTE_OFF + 288 * 4 <= P4TAB_OFF && P4TAB_OFF + 4096 <= LDS_BYTES, "LDS map");

#define GAS __attribute__((address_space(1)))
#define LAS __attribute__((address_space(3)))
typedef unsigned short bf16;
typedef unsigned u32x4 __attribute__((ext_vector_type(4)));
typedef unsigned u32x2 __attribute__((ext_vector_type(2)));
typedef float f32x4 __attribute__((ext_vector_type(4)));
typedef float f32x2 __attribute__((ext_vector_type(2)));
typedef float f32x16 __attribute__((ext_vector_type(16)));
typedef short bf16x8 __attribute__((ext_vector_type(8)));
#define LDS_WAIT() asm volatile("s_waitcnt lgkmcnt(0)" ::: "memory")
#define VM_WAIT() asm volatile("s_waitcnt vmcnt(0)" ::: "memory")

__device__ __forceinline__ unsigned cvt_pk_bf16(float lo, float hi) { unsigned r; asm volatile("v_cvt_pk_bf16_f32 %0, %1, %2" : "=v"(r) : "v"(lo), "v"(hi)); return r; }
__device__ __forceinline__ unsigned cvt_fp8x4(float a, float b, float c, float d) { int w = 0; w = __builtin_amdgcn_cvt_pk_fp8_f32(a, b, w, false); w = __builtin_amdgcn_cvt_pk_fp8_f32(c, d, w, true); return (unsigned)w; }
__device__ __forceinline__ float bf_lo(unsigned w) { return __uint_as_float(w << 16); }
__device__ __forceinline__ float bf_hi(unsigned w) { return __uint_as_float(w & 0xffff0000u); }
#define DPP_ADD(v, ctrl) ((v) + __builtin_bit_cast(float, __builtin_amdgcn_update_dpp(0, __builtin_bit_cast(int, (v)), (ctrl), 0xf, 0xf, true)))
__device__ __forceinline__ float wave_sum(float v) {
    v = DPP_ADD(v, 0xB1); v = DPP_ADD(v, 0x4E); v = DPP_ADD(v, 0x141); v = DPP_ADD(v, 0x140);
    v += __shfl_xor(v, 16); v += __shfl_xor(v, 32);
    return v;
}
namespace pg8 {
#define PG8_LAS __attribute__((address_space(3)))
typedef unsigned short bf16_t;
constexpr int BM = 256, BK = 64, HALF = 128, HTB = HALF * BK * 2, STAGE_BYTES = 8 * HTB, NXCD = 8, WGM = 8;
__host__ __device__ __forceinline__ int lds_byte(int r, int c) { const int st = (r >> 4) * 2 + (c >> 5), rr = r & 15, cc = c & 31, ob = rr * 64 + cc * 2; return st * 1024 + (ob ^ (((ob >> 9) & 1) << 5)); }
__host__ __device__ __forceinline__ void stage_rc(int b, int& R, int& C) { const int st = b / 1024, sb = b % 1024, swz = sb ^ (((sb >> 9) & 1) << 5); R = (st >> 1) * 16 + swz / 64; C = (st & 1) * 32 + (swz % 64) / 2; }
__host__ __device__ __forceinline__ int perm32(int rho) { const int n = rho >> 4, i = rho & 15; return 8 * (i >> 2) + 4 * n + (i & 3); }

typedef int v8i32_t __attribute__((ext_vector_type(8))); typedef int v4i32_t __attribute__((ext_vector_type(4)));
__device__ __forceinline__ v8i32_t cat8(bf16x8 lo, bf16x8 hi) { const v4i32_t a = __builtin_bit_cast(v4i32_t, lo), b = __builtin_bit_cast(v4i32_t, hi); return __builtin_shufflevector(a, b, 0, 1, 2, 3, 4, 5, 6, 7); }
struct Unit { int pm, pn, e; };
template <class T, class = void> struct pg8_tab { static constexpr bool value = false; };
template <class T> struct pg8_tab<T, decltype((void)T::TABLE)> { static constexpr bool value = T::TABLE; };
struct Gemm { const bf16_t* A; const bf16_t* Bt; int K; size_t bexp; };

struct StaticOrder {
    int nM, nN, nwg, G, c;
    __device__ __forceinline__ void init(int M, int N, int G_, int c_) { nM = M / BM; nN = N / BM; nwg = nM * nN; G = G_; c = c_; }
    __device__ __forceinline__ bool next(int i, Unit& u) const {
        const long L = (long)i * G + c; if (L >= nwg) return false;
        int wgid = (int)L; { const int q = nwg / NXCD, r = nwg % NXCD, xcd = wgid % NXCD, off = wgid / NXCD; wgid = (xcd < r ? xcd * (q + 1) : r * (q + 1) + (xcd - r) * q) + off; }
        const int nig = WGM * nN, gid = wgid / nig, fm = gid * WGM, gsz = (nM - fm) < WGM ? (nM - fm) : WGM;
        u.pm = fm + ((wgid % nig) % gsz); u.pn = (wgid % nig) / gsz; u.e = 0; return true;
    }
    __device__ __forceinline__ unsigned row_off(int, int) const { return 0u; }
};

template <class Epi, class Sched, bool GATHER, bool MIDSCALE, bool FP8 = false, bool AHM = false>
__device__ __forceinline__ void gemm_phase(PG8_LAS unsigned char* lds, const Gemm g, const Sched& S, const Epi& E) {
    int tid_ = threadIdx.x; asm volatile("" : "+v"(tid_));
    const int tid = tid_, wid = __builtin_amdgcn_readfirstlane(tid >> 6), lane = tid & 63, wr = wid >> 2, wc = wid & 3, fr = lane & 15, fq = lane >> 4;
    int K_ = g.K; asm volatile("" : "+s"(K_));
    const int K = K_, nt = K / BK;
    unsigned voffA[2], voffB[2], voffB16[2][2]; int RA[2]; unsigned CA2[2];
#pragma unroll
    for (int i = 0; i < 2; ++i) { int R, C; stage_rc(tid * 16 + i * 8192, R, C); const int Rb = Epi::PERM ? ((R & ~31) + perm32(R & 31)) : R;
        voffA[i] = (unsigned)(R * (AHM ? 64 : K) + C) * 2u; voffB[i] = (unsigned)(Rb * K + C) * 2u; RA[i] = R; CA2[i] = (unsigned)C * 2u;
        if constexpr (Epi::PERM16) {
#pragma unroll
            for (int h = 0; h < 2; ++h) { const int g16 = 64 * (R >> 5) + 16 * ((R >> 2) & 3) + 8 * h + 4 * ((R >> 4) & 1) + (R & 3); voffB16[h][i] = (unsigned)(g16 * K + C) * 2u; } } }
    const size_t kstep = (size_t)(BK * 2);
    const size_t hstep = (size_t)HALF * K * 2;
    const size_t tstep = 2 * hstep;
    const size_t kstepA = AHM ? (size_t)SEQ * 64 * 2 : kstep, hstepA = AHM ? (size_t)HALF * 64 * 2 : hstep;
#define PG8_ABASE(pm_) (AHM ? (const char*)g.A + ((size_t)((pm_) >> 3) * (K / 64) * SEQ + (size_t)((pm_) & 7) * 256) * 128 : (const char*)g.A + (size_t)(pm_) * tstep)
    const unsigned ldsw = (unsigned)wid * 1024u;
    const int aoff = lds_byte(wr * 64 + fr, fq * 8), boff = lds_byte(wc * 32 + fr, fq * 8);
#define PG8_SA(b, h) (((b) * 2 + (h)) * HTB)
#define PG8_SB(b, h) ((4 + (b) * 2 + (h)) * HTB)
#define PG8_STAGE(bufoff, gbase, voff) do { _Pragma("unroll") for (int _i = 0; _i < 2; ++_i) \
        __builtin_amdgcn_global_load_lds((const unsigned*)((const char*)(gbase) + (voff)[_i]), (PG8_LAS unsigned*)(lds + (bufoff) + ldsw + _i * 8192), 16, 0, 0); } while (0)
#define PG8_STB(bufoff, p, h) do { if constexpr (Epi::PERM16) { PG8_STAGE(bufoff, p, voffB16[h]); } else { PG8_STAGE(bufoff, (p) + (h) * hstep, voffB); } } while (0)
#define PG8_STA(bufoff, p, h, OFF) do { if constexpr (GATHER) { PG8_STAGE(bufoff, p, (OFF)[h]); } else { PG8_STAGE(bufoff, (p) + (h) * hstepA, voffA); } } while (0)
#define PG8_LDA(dst, b, h) do { _Pragma("unroll") for (int m = 0; m < 4; ++m) { if constexpr (FP8) { dst##8[m] = cat8(*(const PG8_LAS bf16x8*)(lds + PG8_SA(b, h) + aoff + m * 2048), *(const PG8_LAS bf16x8*)(lds + PG8_SA(b, h) + aoff + m * 2048 + 1024)); } \
        else { _Pragma("unroll") for (int k = 0; k < 2; ++k) dst[m][k] = *(const PG8_LAS bf16x8*)(lds + PG8_SA(b, h) + aoff + m * 2048 + k * 1024); } } } while (0)
#define PG8_LDB(dst, b, h) do { _Pragma("unroll") for (int n = 0; n < 2; ++n) { if constexpr (FP8) { dst##8[n] = cat8(*(const PG8_LAS bf16x8*)(lds + PG8_SB(b, h) + boff + n * 2048), *(const PG8_LAS bf16x8*)(lds + PG8_SB(b, h) + boff + n * 2048 + 1024)); } \
        else { _Pragma("unroll") for (int k = 0; k < 2; ++k) dst[n][k] = *(const PG8_LAS bf16x8*)(lds + PG8_SB(b, h) + boff + n * 2048 + k * 1024); } } } while (0)
#define PG8_MMA(ai, bj, At, Bt) do { __builtin_amdgcn_s_setprio(1); _Pragma("unroll") for (int m = 0; m < 4; ++m) _Pragma("unroll") for (int n = 0; n < 2; ++n) { \
        if constexpr (FP8) { asm volatile("v_mfma_scale_f32_16x16x128_f8f6f4 %0, %1, %2, %0, %3, %3 op_sel_hi:[0,0,0]" : "+v"(acc[ai][bj][m][n]) : "v"(Bt##8[n]), "v"(At##8[m]), "v"(fp8_one)); } \
        else { _Pragma("unroll") for (int k = 0; k < 2; ++k) acc[ai][bj][m][n] = __builtin_amdgcn_mfma_f32_16x16x32_bf16(Bt[n][k], At[m][k], acc[ai][bj][m][n], 0, 0, 0); } } \
        __builtin_amdgcn_s_setprio(0); } while (0)
#define PG8_WAIT_V(n) asm volatile("s_waitcnt vmcnt(" #n ")" ::: "memory")
#define PG8_WAIT_V8T() do { if constexpr (pg8_tab<Epi>::value) { if (t == 2) PG8_WAIT_V(10); else PG8_WAIT_V(8); } else PG8_WAIT_V(8); } while (0)
#define PG8_WAIT_L(n) asm volatile("s_waitcnt lgkmcnt(" #n ")" ::: "memory")
#define PG8_BAR __builtin_amdgcn_s_barrier()
#define PG8_SCHED __builtin_amdgcn_sched_barrier(0)
    Unit cur, nxt; int ui = 0;
    if (!S.next(0, cur)) return;
    f32x4 acc[2][2][4][2];
#pragma unroll
    for (int a = 0; a < 2; ++a)
#pragma unroll
        for (int b = 0; b < 2; ++b)
#pragma unroll
            for (int m = 0; m < 4; ++m)
#pragma unroll
                for (int n = 0; n < 2; ++n) acc[a][b][m][n] = (f32x4){0.f, 0.f, 0.f, 0.f};
    bf16x8 At[4][2], B0[2][2], B1[2][2]; v8i32_t At8[4], B08[2], B18[2];
    const int fp8_one = 0x7F7F7F7F;
    unsigned offC[2][2], offN[2][2];
    if constexpr (GATHER) {
#pragma unroll
        for (int h = 0; h < 2; ++h)
#pragma unroll
            for (int i = 0; i < 2; ++i) { offC[h][i] = S.row_off(0, RA[i] + HALF * h) + CA2[i]; offN[h][i] = offC[h][i]; }
    }
    const char* cA = GATHER ? (const char*)g.A : PG8_ABASE(cur.pm);
    const char* cB = (const char*)g.Bt + (size_t)cur.e * g.bexp + (size_t)cur.pn * tstep;
    PG8_STB(PG8_SB(0, 0), cB, 0); PG8_STB(PG8_SB(0, 1), cB, 1); PG8_STA(PG8_SA(0, 0), cA, 0, offC); PG8_STA(PG8_SA(0, 1), cA, 1, offC);
    if (wr == 1) PG8_BAR;
    PG8_WAIT_V(2); PG8_BAR;
    PG8_STB(PG8_SB(1, 0), cB + kstep, 0); PG8_STA(PG8_SA(1, 0), cA + kstepA, 0, offC); PG8_STB(PG8_SB(1, 1), cB + kstep, 1);
    PG8_WAIT_V(6); PG8_BAR;
    for (;;) {
        const bool has_next = S.next(ui + 1, nxt);
        const char* nA = GATHER ? (const char*)g.A : (has_next ? PG8_ABASE(nxt.pm) : cA);
        const char* nB = has_next ? (const char*)g.Bt + (size_t)nxt.e * g.bexp + (size_t)nxt.pn * tstep : cB;
        if constexpr (GATHER) {
            if (has_next) {
#pragma unroll
                for (int h = 0; h < 2; ++h)
#pragma unroll
                    for (int i = 0; i < 2; ++i) offN[h][i] = S.row_off(ui + 1, RA[i] + HALF * h) + CA2[i];
            } else {
#pragma unroll
                for (int h = 0; h < 2; ++h)
#pragma unroll
                    for (int i = 0; i < 2; ++i) offN[h][i] = offC[h][i];
            }
        }
        _Pragma("nounroll") for (int t = 0; t < nt; t += 2) {
            const bool last = (t == nt - 2);
            const char* a1 = cA + (size_t)(t + 1) * kstepA;
            const char* a2 = last ? nA : cA + (size_t)(t + 2) * kstepA; const char* b2 = last ? nB : cB + (size_t)(t + 2) * kstep;
            const char* a3 = a2 + kstepA; const char* b3 = b2 + kstep;
            unsigned o2[2][2];
            if constexpr (GATHER) {
#pragma unroll
                for (int h = 0; h < 2; ++h)
#pragma unroll
                    for (int i = 0; i < 2; ++i) o2[h][i] = last ? offN[h][i] : offC[h][i];
            }
            if constexpr (MIDSCALE) { if (t == nt / 2) E.midscale(acc, ui, wr, fr); }
            PG8_LDB(B0, 0, 0); PG8_LDB(B1, 0, 1); PG8_SCHED; PG8_LDA(At, 0, 0); PG8_STA(PG8_SA(1, 1), a1, 1, offC);
            if constexpr (pg8_tab<Epi>::value) { if (t == 2) E.table_issue(lds, cur, wid, lane); }
            PG8_WAIT_V8T(); PG8_WAIT_L(0); PG8_BAR; PG8_MMA(0, 0, At, B0); PG8_MMA(0, 1, At, B1); PG8_BAR; PG8_SCHED;
            PG8_LDA(At, 0, 1); PG8_STB(PG8_SB(0, 0), b2, 0); PG8_STB(PG8_SB(0, 1), b2, 1); PG8_STA(PG8_SA(0, 0), a2, 0, o2);
            PG8_WAIT_V8T(); PG8_WAIT_L(0); PG8_BAR; PG8_MMA(1, 0, At, B0); PG8_MMA(1, 1, At, B1); PG8_BAR; PG8_SCHED;
            PG8_LDB(B0, 1, 0); PG8_LDB(B1, 1, 1); PG8_SCHED; PG8_LDA(At, 1, 0); PG8_STA(PG8_SA(0, 1), a2, 1, o2);
            PG8_WAIT_V(8); PG8_WAIT_L(0); PG8_BAR; PG8_MMA(0, 0, At, B0); PG8_MMA(0, 1, At, B1); PG8_BAR; PG8_SCHED;
            PG8_LDA(At, 1, 1); PG8_STB(PG8_SB(1, 0), b3, 0); PG8_STB(PG8_SB(1, 1), b3, 1); PG8_STA(PG8_SA(1, 0), a3, 0, o2);
            PG8_WAIT_V(8); PG8_WAIT_L(0); PG8_BAR; PG8_MMA(1, 0, At, B0); PG8_MMA(1, 1, At, B1); PG8_BAR; PG8_SCHED;
        }
        if (wr == 0) PG8_BAR;
        if constexpr (FP8) {
#pragma unroll
            for (int a = 0; a < 2; ++a)
#pragma unroll
                for (int b = 0; b < 2; ++b)
                    asm volatile("s_nop 15\n\ts_nop 15" : "+v"(acc[a][b][0][0]), "+v"(acc[a][b][0][1]), "+v"(acc[a][b][1][0]), "+v"(acc[a][b][1][1]), "+v"(acc[a][b][2][0]), "+v"(acc[a][b][2][1]), "+v"(acc[a][b][3][0]), "+v"(acc[a][b][3][1]));
        }
        E(acc, cur, ui, wr, wc, fr, fq);
        if (!has_next) break;
#pragma unroll
        for (int a = 0; a < 2; ++a)
#pragma unroll
            for (int b = 0; b < 2; ++b)
#pragma unroll
                for (int m = 0; m < 4; ++m)
#pragma unroll
                    for (int n = 0; n < 2; ++n) acc[a][b][m][n] = (f32x4){0.f, 0.f, 0.f, 0.f};
        cur = nxt; cA = nA; cB = nB; ++ui;
        if constexpr (GATHER) {
#pragma unroll
            for (int h = 0; h < 2; ++h)
#pragma unroll
                for (int i = 0; i < 2; ++i) offC[h][i] = offN[h][i];
        }
        if (wr == 1) PG8_BAR;
    }
    PG8_WAIT_V(0);
    PG8_BAR;
#undef PG8_SA
#undef PG8_ABASE
#undef PG8_SB
#undef PG8_STAGE
#undef PG8_STA
#undef PG8_STB
#undef PG8_LDA
#undef PG8_LDB
#undef PG8_MMA
#undef PG8_WAIT_V
#undef PG8_WAIT_V8T
#undef PG8_WAIT_L
#undef PG8_BAR
#undef PG8_SCHED
}
}

#define XB_TMO      128
#define XB_XCNT(j)  (256  + 64 * (j))
#define XB_XSUB(j)  (1280 + 64 * (j))
#define XB_XGEN(j)  (2304 + 64 * (j))
#define XB_TOP      3328
#define XB_TOPGEN   3392
#define XCD_BAR_WORDS 3456
#define XB_SPIN_CAP (1u << 18)

__device__ __forceinline__ unsigned xb_ld(unsigned* p)              { return __hip_atomic_load(p, __ATOMIC_RELAXED, __HIP_MEMORY_SCOPE_AGENT); }
__device__ __forceinline__ unsigned xb_add(unsigned* p, unsigned v) { return __hip_atomic_fetch_add(p, v, __ATOMIC_RELAXED, __HIP_MEMORY_SCOPE_AGENT); }
__device__ __forceinline__ unsigned xb_xcc_id() { return (unsigned)__builtin_amdgcn_s_getreg((3 << 11) | 20) & 0xFu; }
#define XB_SPIN(cond, bar) do { unsigned _sp = 0; while (cond) { __builtin_amdgcn_s_sleep(1); \
    if ((++_sp & 255u) == 0u) { if (xb_ld(&(bar)[XB_TMO])) break; if (_sp > XB_SPIN_CAP) { atomicAdd(&(bar)[XB_TMO], 1u); break; } } } } while (0)

struct XcdBarrier {
    unsigned* bar; unsigned x;
    volatile LAS unsigned* st;
};
__device__ __forceinline__ XcdBarrier xcd_barrier_post(unsigned* bar, volatile LAS unsigned* st) {
    XcdBarrier b; b.bar = bar; b.x = xb_xcc_id(); b.st = st;
    if (threadIdx.x == 0) (void)xb_add(&bar[XB_XCNT(b.x)], 1u);
    return b;
}
__device__ __forceinline__ void xcd_barrier_complete(unsigned* bar, unsigned x, unsigned& nloc, unsigned& nx) {
    const unsigned G = gridDim.x * gridDim.y * gridDim.z;
    unsigned sum, cnt, mine, sp = 0u;
    for (;;) {
        sum = 0u; cnt = 0u; mine = 0u;
#pragma unroll
        for (unsigned j = 0; j < 16; ++j) { const unsigned c = xb_ld(&bar[XB_XCNT(j)]); sum += c; cnt += (c > 0u) ? 1u : 0u; mine = (j == x) ? c : mine; }
        if (sum == G) break;
        __builtin_amdgcn_s_sleep(1);
        if ((++sp & 255u) == 0u) { if (xb_ld(&bar[XB_TMO])) break; if (sp > XB_SPIN_CAP) { atomicAdd(&bar[XB_TMO], 1u); break; } }
    }
    nloc = mine > 0u ? mine : 1u; nx = cnt > 0u ? cnt : 1u;
}
__device__ __forceinline__ void xcd_barrier(const XcdBarrier& b) {
    asm volatile("s_waitcnt vmcnt(0)" ::: "memory");
    __syncthreads();
    if (threadIdx.x == 0) {
        unsigned* bar = b.bar;
        __builtin_amdgcn_s_waitcnt(0);
        unsigned nloc = b.st[0], nx = b.st[1];
        if (nloc == 0u) { xcd_barrier_complete(bar, b.x, nloc, nx); b.st[0] = nloc; b.st[1] = nx; }
        const unsigned old = xb_add(&bar[XB_XSUB(b.x)], 1u);
        const unsigned gen = old / nloc;
        if (old + 1u == (gen + 1u) * nloc) {
            __builtin_amdgcn_fence(__ATOMIC_RELEASE, "agent");
            asm volatile("s_waitcnt vmcnt(0)" ::: "memory");
            const unsigned og = xb_add(&bar[XB_TOP], 1u);
            const unsigned tg = og / nx;
            if (og + 1u == (tg + 1u) * nx) xb_add(&bar[XB_TOPGEN], 1u);
            else XB_SPIN(xb_ld(&bar[XB_TOPGEN]) == tg, bar);
            __builtin_amdgcn_fence(__ATOMIC_ACQUIRE, "agent");
            xb_add(&bar[XB_XGEN(b.x)], 1u);
            asm volatile("s_waitcnt vmcnt(0)" ::: "memory");
        } else {
            XB_SPIN(xb_ld(&bar[XB_XGEN(b.x)]) == gen, bar);
            __builtin_amdgcn_fence(__ATOMIC_ACQUIRE, "agent");
            asm volatile("s_waitcnt vmcnt(0)" ::: "memory");
        }
    }
    __syncthreads();
}

struct Frame {
    LAS unsigned char* lds;
    unsigned* ctl;
    int tid, lane, wave, vcu, G;
    const float* const* in;
    float* out; unsigned char* ws;
};
#define IN_x (F.in[0])
#define IN_c (F.in[1])
#define IN_w_in (F.in[2])
#define IN_w_out (F.in[3])
#define IN_sinks (F.in[4])
#define IN_rel_bias (F.in[5])
#define IN_norm_a (F.in[6])
#define IN_norm_b (F.in[7])
#define IN_w_ada (F.in[8])
#define IN_b_ada (F.in[9])
#define IN_ln1_g (F.in[10])
#define IN_ln1_b (F.in[11])
#define IN_ln2_g (F.in[12])
#define IN_ln2_b (F.in[13])
#define IN_w_grp (F.in[14])
#define IN_b_grp (F.in[15])
#define IN_w_rtr (F.in[16])
#define IN_b_rtr (F.in[17])
#define IN_w_gate (F.in[18])
#define IN_w_up (F.in[19])
#define IN_w_down (F.in[20])

struct CvtItem { const float* src; const float* kgain; bf16* dst0; int ldw, ldd; float scol; };
__device__ __forceinline__ void cvt_load(const CvtItem& it, f32x4 (&a)[8], f32x4 (&b)[8], int lane) {
#pragma unroll
    for (int i = 0; i < 8; ++i) { const int idx = lane + 64 * i, kk2 = idx >> 4, c4 = idx & 15; const float* p = it.src + (size_t)(2 * kk2) * it.ldw + 4 * c4;
        a[i] = __builtin_nontemporal_load((const f32x4*)p); b[i] = __builtin_nontemporal_load((const f32x4*)(p + it.ldw)); }
}
__device__ __forceinline__ void cvt_store(const CvtItem& it, const f32x4 (&a)[8], const f32x4 (&b)[8], LAS unsigned* img, int lane) {
#pragma unroll
    for (int i = 0; i < 8; ++i) { const int idx = lane + 64 * i, kk2 = idx >> 4, c4 = idx & 15; float ga = it.scol, gb = it.scol;
        if (it.kgain) { ga *= it.kgain[2 * kk2]; gb *= it.kgain[2 * kk2 + 1]; }
#pragma unroll
        for (int j = 0; j < 4; ++j) img[(4 * c4 + j) * 33 + kk2] = cvt_pk_bf16(a[i][j] * ga, b[i][j] * gb); }
    LDS_WAIT(); asm volatile("" ::: "memory");
#pragma unroll
    for (int i = 0; i < 8; ++i) { const int idx = lane + 64 * i, n = idx >> 3, ch = idx & 7; const LAS unsigned* s = img + n * 33 + 4 * ch;
        u32x4 v; v.x = s[0]; v.y = s[1]; v.z = s[2]; v.w = s[3];
        *(u32x4*)(it.dst0 + (size_t)n * it.ldd + 8 * ch) = v; }
    LDS_WAIT(); asm volatile("" ::: "memory");
}
constexpr int CVT_I_IN = 32 * 68, CVT_I_OUT = 32 * 32, CVT_NITEMS = CVT_I_IN + CVT_I_OUT;
__device__ __forceinline__ CvtItem cvt_decode(Frame& F, int r) {
    bf16* WIN = (bf16*)(F.ws + WS_WIN); bf16* WOUT = (bf16*)(F.ws + WS_WOUT);
    CvtItem it;
    if (r < CVT_I_IN) { const int kb = r / 68, nb = r % 68, n0 = 64 * nb; it.scol = (n0 < 1024 || (n0 >= COL_QB && n0 < COL_KB)) ? QSCALE : 1.f;
        it.src = IN_w_in + (size_t)(64 * kb) * QKVD + n0; it.ldw = QKVD; it.kgain = nullptr; it.dst0 = WIN + (size_t)n0 * DM + 64 * kb; it.ldd = DM; return it; }
    r -= CVT_I_IN;
    { const int kb = r / 32, nb = r % 32, k0 = 64 * kb; it.scol = 1.f; it.kgain = k0 < 1024 ? IN_norm_a + k0 : IN_norm_b + (k0 - 1024);
      it.src = IN_w_out + (size_t)k0 * DM + 64 * nb; it.ldw = DM; it.dst0 = WOUT + (size_t)(64 * nb) * DM + k0; it.ldd = DM; return it; }
}
__device__ __forceinline__ void cvt8_item(const float* __restrict__ src, int ldw, float scol, unsigned char* dst0, int ldd, LAS unsigned* img, int lane) {
    f32x4 v[8][4];
#pragma unroll
    for (int i = 0; i < 8; ++i) { const int idx = lane + 64 * i, kk4 = idx >> 4, c4 = idx & 15; const float* p = src + (size_t)(4 * kk4) * ldw + 4 * c4;
#pragma unroll
        for (int q = 0; q < 4; ++q) v[i][q] = __builtin_nontemporal_load((const f32x4*)(p + (size_t)q * ldw)); }
#pragma unroll
    for (int i = 0; i < 8; ++i) { const int idx = lane + 64 * i, kk4 = idx >> 4, c4 = idx & 15;
#pragma unroll
        for (int j = 0; j < 4; ++j) img[(4 * c4 + j) * 33 + kk4] = cvt_fp8x4(v[i][0][j] * scol, v[i][1][j] * scol, v[i][2][j] * scol, v[i][3][j] * scol); }
    LDS_WAIT(); asm volatile("" ::: "memory");
#pragma unroll
    for (int i = 0; i < 8; ++i) { const int idx = lane + 64 * i, n = idx >> 3, ch = idx & 7; const LAS unsigned* sp = img + n * 33 + 4 * ch;
        u32x4 w; w.x = sp[0]; w.y = sp[1]; w.z = sp[2]; w.w = sp[3];
        *(u32x4*)(dst0 + (size_t)n * ldd + 16 * ch) = w; }
    LDS_WAIT(); asm volatile("" ::: "memory");
}

constexpr int CVT8_PRE2 = 2;
constexpr int CVT8_EXTRA = 1024;
constexpr int CVT8_N = 2 * 32 * 16 * 8 + 32 * 4 * 32, CVT8_DEFER2 = 5120, CVT8_DEFER6 = 3328, CVT8_DEFER4 = 2048, QKV_UNITS = (TOK / 256) * (QKVD / 256);
static_assert(CVT8_N - CVT8_DEFER6 >= 2 * 32 * 16 * 8, "the items deferred to the gate/up phase must be down-projection tiles");
__device__ __forceinline__ int cvt8_short(int G) { const int rem = QKV_UNITS % G; return rem == 0 ? 0 : G - rem; }
__device__ __forceinline__ int cvt8_split(int G) { return CVT8_N - CVT8_DEFER6 - (cvt8_short(G) > 0 ? CVT8_DEFER2 : 0) - CVT8_DEFER4; }
__device__ __forceinline__ void cvt8_run(Frame& F, int r, LAS unsigned* img, int lane) {
    unsigned char* WGU = F.ws + WS_WGU; unsigned char* WDN = F.ws + WS_WDN;
    constexpr int I_G = 32 * 16 * 8;
    if (r < 2 * I_G) { const int up = r >= I_G, rr = up ? r - I_G : r; const int e = rr / 128, q = rr % 128, kb = q / 8, nb = q % 8, j0 = 64 * nb;
        const int drow = 256 * (j0 >> 7) + (up ? 128 : 0) + (j0 & 127);
        cvt8_item((up ? IN_w_up : IN_w_gate) + (size_t)e * DM * DEXP + (size_t)(128 * kb) * DEXP + j0, DEXP, W_GU_SCALE, WGU + ((size_t)e * 1024 + drow) * DM + 128 * kb, DM, img, lane);
    } else { const int rr = r - 2 * I_G; const int e = rr / 128, q = rr % 128, kb = q / 32, nb = q % 32;
        cvt8_item(IN_w_down + (size_t)e * DEXP * DM + (size_t)(128 * kb) * DM + 64 * nb, DM, W_DN_SCALE, WDN + ((size_t)e * DM + 64 * nb) * DEXP + 128 * kb, DEXP, img, lane); }
}
__device__ __forceinline__ void cvt8_deferred2(Frame& F, int part) {
    const int ns = cvt8_short(F.G), first = F.G - ns, c = (int)blockIdx.x;
    int lane = F.lane; asm volatile("" : "+v"(lane));
    if (ns > 0 && c >= first) { LAS unsigned* img = (LAS unsigned*)(F.lds + F.wave * 8448); const int lo = cvt8_split(F.G) + CVT8_DEFER4, hi = lo + CVT8_DEFER2, stride = ns * 8;
        const int r0 = lo + (c - first) * 8 + F.wave, rmid = r0 + CVT8_PRE2 * stride;
        if (part == 0) { for (int r = r0; r < hi && r < rmid; r += stride) cvt8_run(F, r, img, lane); }
        else { for (int r = rmid; r < hi; r += stride) cvt8_run(F, r, img, lane); } }
}
__device__ __forceinline__ void cvt8_deferred4(Frame& F) {
    int lane = F.lane; asm volatile("" : "+v"(lane));
    if (F.vcu & 1) { LAS unsigned* img = (LAS unsigned*)(F.lds + F.wave * 8448); const int lo = cvt8_split(F.G), hi = lo + CVT8_DEFER4;
        for (int r = lo + (F.vcu >> 1) * 8 + F.wave; r < hi; r += (F.G >> 1) * 8) cvt8_run(F, r, img, lane); }
}
__device__ __forceinline__ void cvt8_deferred6(Frame& F, int units) {
    const int rem = units % F.G, ns = F.G - rem; const bool all = rem == 0 || ns < 64;
    int lane = F.lane; asm volatile("" : "+v"(lane));
    const int idx = all ? F.vcu : F.vcu - rem, cnt = all ? F.G : ns;
    if (idx >= 0) { LAS unsigned* img = (LAS unsigned*)(F.lds + F.wave * 8448);
        for (int r = CVT8_N - CVT8_DEFER6 + idx * 8 + F.wave; r < CVT8_N; r += cnt * 8) cvt8_run(F, r, img, lane); }
}
__device__ __forceinline__ void p0_prologue(Frame& F) {
    float* mod = (float*)(F.ws + WS_MOD);
    const bool spread = (F.G == 256); const bool freewg = spread && (F.vcu & 3) == 3;
    for (int ab = spread ? (freewg ? 192 : (F.vcu >> 2) * 3 + (F.vcu & 3)) : F.vcu; ab < 192; ab += spread ? 192 : F.G) {
        LAS float* cact = (LAS float*)F.lds;
        for (int idx = F.tid; idx < 16 * 2048; idx += 512) { const int b = idx >> 11, k = idx & 2047; const float v = IN_c[idx]; cact[k * 16 + b] = v * __builtin_amdgcn_rcpf(1.f + __builtin_amdgcn_exp2f(-v * LOG2E)); }
        __syncthreads();
        const int cc = F.lane & 15, kk = F.lane >> 4;
        f32x4 acc[4];
#pragma unroll
        for (int j = 0; j < 4; ++j) acc[j] = (f32x4){0.f, 0.f, 0.f, 0.f};
        const float* wp = IN_w_ada + 64 * ab + 4 * cc + (size_t)(256 * F.wave + kk) * 12288;
        const LAS float* ap = cact + (256 * F.wave + kk) * 16 + cc;
#pragma unroll 16
        for (int st = 0; st < 64; ++st) { const f32x4 w = __builtin_nontemporal_load((const f32x4*)(wp + (size_t)(4 * st) * 12288)); const float av = ap[4 * st * 16];
#pragma unroll
            for (int j = 0; j < 4; ++j) acc[j] = __builtin_amdgcn_mfma_f32_16x16x4f32(av, w[j], acc[j], 0, 0, 0); }
        __syncthreads();
        LAS float* red = (LAS float*)F.lds;
#pragma unroll
        for (int j = 0; j < 4; ++j)
#pragma unroll
            for (int r = 0; r < 4; ++r) red[(F.wave * 16 + 4 * kk + r) * 64 + 4 * cc + j] = acc[j][r];
        __syncthreads();
        for (int o = F.tid; o < 1024; o += 512) { const int b = o >> 6, col = o & 63; float sm = 0.f;
#pragma unroll
            for (int w = 0; w < 8; ++w) sm += red[(w * 16 + b) * 64 + col];
            mod[b * 12288 + 64 * ab + col] = sm + IN_b_ada[64 * ab + col]; }
        __syncthreads();
    }
    { bf16* wh = (bf16*)(F.ws + WS_WR); bf16* wl = wh + 48 * 2048;
      for (int idx = F.vcu * 512 + F.tid; idx < 48 * 2048; idx += F.G * 512) { const int c = idx >> 11, k = idx & 2047;
          const float v = c < 4 ? IN_w_grp[k * 4 + c] : (c < 36 ? IN_w_rtr[k * 32 + (c - 4)] : 0.f);
          const unsigned h = cvt_pk_bf16(v, 0.f) & 0xffffu; const float r = v - bf_lo(h);
          wh[idx] = (bf16)h; wl[idx] = (bf16)(cvt_pk_bf16(r, 0.f) & 0xffffu); } }
    LAS unsigned* img = (LAS unsigned*)(F.lds + F.wave * 8448);
    const int gw = F.vcu * 8 + F.wave, NGW = F.G * 8;
    f32x4 a0[8], b0[8], a1[8], b1[8]; CvtItem i0, i1;
    int it = gw;
    if (it < CVT_NITEMS) { i0 = cvt_decode(F, it); cvt_load(i0, a0, b0, F.lane); }
    for (; it < CVT_NITEMS; it += 2 * NGW) {
        const bool h1 = it + NGW < CVT_NITEMS, h2 = it + 2 * NGW < CVT_NITEMS;
        if (h1) { i1 = cvt_decode(F, it + NGW); cvt_load(i1, a1, b1, F.lane); }
        cvt_store(i0, a0, b0, img, F.lane);
        if (h2) { i0 = cvt_decode(F, it + 2 * NGW); cvt_load(i0, a0, b0, F.lane); }
        if (h1) cvt_store(i1, a1, b1, img, F.lane);
    }
    const int n0 = cvt8_split(F.G), ex = spread ? CVT8_EXTRA : 0;
    if (freewg) for (int r = (F.vcu >> 2) * 8 + F.wave; r < ex; r += 512) cvt8_run(F, r, img, F.lane);
    for (int r = ex + gw; r < n0; r += NGW) cvt8_run(F, r, img, F.lane);
}

__device__ __forceinline__ void p1_modulate(Frame& F) {
    const float* mod = (const float*)(F.ws + WS_MOD); bf16* H = (bf16*)(F.ws + WS_H);
    LAS float* sc = (LAS float*)F.lds; LAS float* sh = sc + 2048;
    for (int blk = F.vcu; blk < 256; blk += F.G) {
        const int b = blk >> 4;
        for (int k = F.tid; k < 2048; k += 512) { sc[k] = 1.f + mod[b * 12288 + 2048 + k]; sh[k] = mod[b * 12288 + k]; }
        if ((blk & 15) == 0) { float* T = (float*)(F.ws + WS_P4TAB) + (size_t)b * 4 * 2048;
            for (int k = F.tid; k < 2048; k += 512) { const float ca = ALPHA_DN / (1.f + mod[b * 12288 + 2048 + k]); T[k] = ca; T[2048 + k] = -mod[b * 12288 + k] * ca; T[4096 + k] = 1.f + mod[b * 12288 + 4096 + k]; T[6144 + k] = 0.f; } }
        __syncthreads();
        for (int r = F.wave; r < 128; r += 16) { const size_t row = (size_t)blk * 128 + r;
            f32x4 xv[2][8];
#pragma unroll
            for (int q = 0; q < 2; ++q)
#pragma unroll
                for (int j = 0; j < 8; ++j) xv[q][j] = __builtin_nontemporal_load((const f32x4*)(IN_x + (row + 8 * q) * DM + 4 * F.lane + 256 * j));
#pragma unroll
            for (int q = 0; q < 2; ++q)
#pragma unroll
                for (int j = 0; j < 8; ++j) { const int col = 4 * F.lane + 256 * j;
                    const f32x4 s4 = *(const LAS f32x4*)(sc + col), t4 = *(const LAS f32x4*)(sh + col); const f32x4 h = xv[q][j] * s4 + t4;
                    u32x2 w; w.x = cvt_pk_bf16(h[0], h[1]); w.y = cvt_pk_bf16(h[2], h[3]); *(u32x2*)(H + (row + 8 * q) * DM + col) = w; } }
        __syncthreads();
    }
}

struct EpiStoreBf16 {
    static constexpr bool PERM = true, PERM16 = true;
    bf16* O; int ldc; float sc;
    __device__ __forceinline__ void operator()(const f32x4 (&acc)[2][2][4][2], const pg8::Unit& u, int ui, int wr, int wc, int fr, int fq) const {
        const int bb = (u.pm * 256) >> 11, s0 = (u.pm * 256) & 2047;
        bf16* base = O + (((size_t)(u.pn * 4 + wc) * NBATCH + bb) * SEQ + s0 + wr * 64 + fr) * 64 + 16 * fq;
#pragma unroll
        for (int ai = 0; ai < 2; ++ai)
#pragma unroll
            for (int m = 0; m < 4; ++m) { bf16* rowp = base + (size_t)(ai * 128 + m * 16) * 64;
#pragma unroll
                for (int bj = 0; bj < 2; ++bj) { const f32x4 v0 = acc[ai][bj][m][0] * sc, v1 = acc[ai][bj][m][1] * sc;
                    u32x4 w; w.x = cvt_pk_bf16(v0[0], v0[1]); w.y = cvt_pk_bf16(v0[2], v0[3]); w.z = cvt_pk_bf16(v1[0], v1[1]); w.w = cvt_pk_bf16(v1[2], v1[3]);
                    *(u32x4*)(rowp + bj * 8) = w; } }
    }
};
struct EpiStoreFp8 {
    static constexpr bool PERM = true, PERM16 = true;
    unsigned char* O; int ldc; float sc;
    __device__ __forceinline__ void operator()(const f32x4 (&acc)[2][2][4][2], const pg8::Unit& u, int ui, int wr, int wc, int fr, int fq) const {
        const int row0 = u.pm * 256 + wr * 64 + fr, col0 = u.pn * 256 + wc * 64 + 16 * fq;
#pragma unroll
        for (int ai = 0; ai < 2; ++ai)
#pragma unroll
            for (int m = 0; m < 4; ++m) { unsigned char* rowp = O + (size_t)(row0 + ai * 128 + m * 16) * ldc + col0;
                const f32x4 a0 = acc[ai][0][m][0] * sc, a1 = acc[ai][0][m][1] * sc, b0 = acc[ai][1][m][0] * sc, b1 = acc[ai][1][m][1] * sc;
                u32x4 w; w.x = cvt_fp8x4(a0[0], a0[1], a0[2], a0[3]); w.y = cvt_fp8x4(a1[0], a1[1], a1[2], a1[3]); w.z = cvt_fp8x4(b0[0], b0[1], b0[2], b0[3]); w.w = cvt_fp8x4(b1[0], b1[1], b1[2], b1[3]);
                *(u32x4*)rowp = w; }
    }
};
__device__ __forceinline__ float silu_mul(float g, float u) { return g * __builtin_amdgcn_rcpf(1.f + __builtin_amdgcn_exp2f(-g * LOG2E)) * u; }
struct EpiSwiGLU {
    static constexpr bool PERM = true, PERM16 = false;
    unsigned char* ACT;
    __device__ __forceinline__ void operator()(const f32x4 (&acc)[2][2][4][2], const pg8::Unit& u, int ui, int wr, int wc, int fr, int fq) const {
        const int row0 = u.pm * 256 + wr * 64 + fr, col0 = u.pn * 128 + wc * 32 + 8 * fq; constexpr float is = 1.f / W_GU_SCALE;
#pragma unroll
        for (int ai = 0; ai < 2; ++ai)
#pragma unroll
            for (int m = 0; m < 4; ++m) { const f32x4 g0 = acc[ai][0][m][0] * is, g1 = acc[ai][0][m][1] * is, u0 = acc[ai][1][m][0] * (is * ACT_SCALE), u1 = acc[ai][1][m][1] * (is * ACT_SCALE);
                u32x2 w; w.x = cvt_fp8x4(silu_mul(g0[0], u0[0]), silu_mul(g0[1], u0[1]), silu_mul(g0[2], u0[2]), silu_mul(g0[3], u0[3]));
                w.y = cvt_fp8x4(silu_mul(g1[0], u1[0]), silu_mul(g1[1], u1[1]), silu_mul(g1[2], u1[2]), silu_mul(g1[3], u1[3]));
                *(u32x2*)(ACT + (size_t)(row0 + ai * 128 + m * 16) * DEXP + col0) = w; }
    }
};
struct EpiOutProj {
    static constexpr bool PERM = true, PERM16 = false, TABLE = true;
    const bf16* h1; const float* tab; const LAS float* rsL; bf16* y1; float* stats;
    __device__ __forceinline__ void midscale(f32x4 (&acc)[2][2][4][2], int ui, int wr, int fr) const {
#pragma unroll
        for (int ai = 0; ai < 2; ++ai)
#pragma unroll
            for (int m = 0; m < 4; ++m) { const float ratio = rsL[(ui * 256 + ai * 128 + wr * 64 + m * 16 + fr) * 2];
#pragma unroll
                for (int bj = 0; bj < 2; ++bj)
#pragma unroll
                    for (int n = 0; n < 2; ++n) acc[ai][bj][m][n] = acc[ai][bj][m][n] * ratio; }
    }
    __device__ __forceinline__ void table_issue(LAS unsigned char* lds, const pg8::Unit& u, int wid, int lane) const {
        const int b = (u.pm * 256) >> 11;
#pragma unroll
        for (int j = 0; j < 2; ++j) { const int q = 2 * wid + j;
            __builtin_amdgcn_global_load_lds((const unsigned*)(tab + ((size_t)(b * 4 + (q >> 2)) * 2048 + u.pn * 256 + 64 * (q & 3) + lane)), (LAS unsigned*)(lds + P4TAB_OFF + q * 256), 4, 0, 0); }
    }
    __device__ __forceinline__ void operator()(const f32x4 (&acc)[2][2][4][2], const pg8::Unit& u, int ui, int wr, int wc, int fr, int fq) const {
        const int col0 = u.pn * 256 + wc * 32 + 8 * fq;
        const LAS float* T = (const LAS float*)((const LAS unsigned char*)rsL - RS_OFF + P4TAB_OFF) + wc * 32 + 8 * fq;
        constexpr int P4_D = 5;
        u32x4 xq[P4_D][2];
#define P4_ROW(st) ((size_t)u.pm * 256 + ((st) >> 2) * 128 + wr * 64 + ((st) & 3) * 16 + fr)
#define P4_ISSUE(st) do { const size_t off_ = P4_ROW(st) * DM + col0; _Pragma("unroll") for (int bj = 0; bj < 2; ++bj) xq[(st) % P4_D][bj] = *(const u32x4*)(h1 + off_ + bj * 128); } while (0)
#pragma unroll
        for (int st = 0; st < P4_D; ++st) P4_ISSUE(st);
        asm volatile("" ::: "memory");
#pragma unroll
        for (int st = 0; st < 8; ++st) { const int ai = st >> 2, m = st & 3; const size_t row = P4_ROW(st); const float rb = rsL[(ui * 256 + ai * 128 + wr * 64 + m * 16 + fr) * 2 + 1]; float s = 0.f, q = 0.f;
#pragma unroll
            for (int bj = 0; bj < 2; ++bj) { const size_t off = row * DM + col0 + bj * 128; const u32x4 xw = xq[st % P4_D][bj];
                f32x4 v[2];
#pragma unroll
                for (int n = 0; n < 2; ++n) { const LAS float* tp = T + bj * 128 + n * 4;
                    const f32x4 ca = *(const LAS f32x4*)tp, cb = *(const LAS f32x4*)(tp + 256), gv = *(const LAS f32x4*)(tp + 512);
                    const unsigned w0 = n ? xw.z : xw.x, w1 = n ? xw.w : xw.y;
                    const f32x4 x4 = (f32x4){bf_lo(w0), bf_hi(w0), bf_lo(w1), bf_hi(w1)};
                    v[n] = (x4 * ca + cb) + gv * (acc[ai][bj][m][n] * rb); }
                const f32x4 v0 = v[0], v1 = v[1];
                u32x4 w; w.x = cvt_pk_bf16(v0[0], v0[1]); w.y = cvt_pk_bf16(v0[2], v0[3]); w.z = cvt_pk_bf16(v1[0], v1[1]); w.w = cvt_pk_bf16(v1[2], v1[3]); *(u32x4*)(y1 + off) = w;
                s += ((v0[0] + v0[1]) + (v0[2] + v0[3])) + ((v1[0] + v1[1]) + (v1[2] + v1[3]));
                q += ((v0[0] * v0[0] + v0[1] * v0[1]) + (v0[2] * v0[2] + v0[3] * v0[3])) + ((v1[0] * v1[0] + v1[1] * v1[1]) + (v1[2] * v1[2] + v1[3] * v1[3])); }
            s += __shfl_xor(s, 16); s += __shfl_xor(s, 32); q += __shfl_xor(q, 16); q += __shfl_xor(q, 32);
            if (fq == 0) *(f32x2*)(stats + (row * 32 + u.pn * 4 + wc) * 2) = (f32x2){s, q};
            if (st + P4_D < 8) P4_ISSUE(st + P4_D);
            asm volatile("" ::: "memory"); }
#undef P4_ROW
#undef P4_ISSUE
    }
};

struct MoeOrder {
    const LAS int* tst; const LAS int* cnt; const int* list; int nN, G, c, NT; const LAS unsigned* rowtab; const LAS int* rte; int xo;
    __device__ __forceinline__ bool next(int i, pg8::Unit& u) const {
        if (xo) {
            const int x4 = (c >> 5) * 4, U = i * 32 + (c & 31), rt = tst[x4] + U / nN;
            if (rt >= tst[x4 + 4]) return false;
            u.pn = U % nN; u.pm = rt; u.e = rte[rt]; return true; }
        const long L = (long)i * G + c; if (L >= (long)NT * nN) return false;
        const int rt = (int)(L / nN); u.pn = (int)(L % nN); u.pm = rt; u.e = rte[rt]; return true;
    }
    __device__ __forceinline__ unsigned row_off(int ui, int r) const { return rowtab[ui * 256 + r]; }
    __device__ __forceinline__ void fill_rowtab(LAS unsigned* tab, int tid) const {
        pg8::Unit u;
        for (int i = 0; i < 8 && next(i, u); ++i) if (tid < 256) { const int pos = (u.pm - tst[u.e]) * 256 + tid; const int tok = pos < cnt[u.e] ? list[u.e * LCAP + pos] : 0; tab[i * 256 + tid] = (unsigned)tok * (unsigned)DM; }
    }
};

__device__ __forceinline__ f32x16 mfma32(bf16x8 a, bf16x8 b, f32x16 c) { return __builtin_amdgcn_mfma_f32_32x32x16_bf16(a, b, c, 0, 0, 0); }
__device__ __forceinline__ void vt_store(LAS unsigned char* wl, const bf16x8 (&vv)[4], int lane) {
    const int key = lane & 31;
#pragma unroll
    for (int i = 0; i < 4; ++i) { const int d8 = (lane >> 5) + 2 * i;
#pragma unroll
        for (int j = 0; j < 8; ++j) *(LAS short*)(wl + (8 * d8 + j) * 80 + key * 2) = vv[i][j]; }
}
__device__ __forceinline__ void pv_tile(f32x16 (&o)[2], LAS unsigned char* wl, const bf16x8 (&pb)[2], int r32, int hi) {
#pragma unroll
    for (int db = 0; db < 2; ++db)
#pragma unroll
        for (int m = 0; m < 2; ++m) { const bf16x8 vf = *(const LAS bf16x8*)(wl + (32 * db + r32) * 80 + (16 * hi + 8 * m) * 2); o[db] = mfma32(vf, pb[m], o[db]); }
}
__device__ __forceinline__ float o_store(const f32x16 (&o)[2], float sc, bf16* orow, int hi) {
    float ss = 0.f;
#pragma unroll
    for (int db = 0; db < 2; ++db)
#pragma unroll
        for (int g = 0; g < 4; ++g) { const float a = o[db][4 * g] * sc, b = o[db][4 * g + 1] * sc, c = o[db][4 * g + 2] * sc, d = o[db][4 * g + 3] * sc;
            ss += (a * a + b * b) + (c * c + d * d); u32x2 w; w.x = cvt_pk_bf16(a, b); w.y = cvt_pk_bf16(c, d); *(u32x2*)(orow + 32 * db + 8 * g + 4 * hi) = w; }
    return ss;
}

constexpr int IMG_PITCH = 144;
__device__ __forceinline__ const bf16* qh_base(const bf16* QH, int g, int b) { return QH + ((size_t)g * NBATCH + b) * SEQ * 64; }
#define WG_BAR() do { asm volatile("s_waitcnt lgkmcnt(0)" ::: "memory"); __builtin_amdgcn_s_barrier(); asm volatile("" ::: "memory"); } while (0)
typedef short v4i16_t __attribute__((ext_vector_type(4)));
__device__ __forceinline__ v4i16_t vtr(const LAS unsigned char* p) { return __builtin_amdgcn_ds_read_tr16_b64_v4i16((LAS v4i16_t*)p); }
__device__ __forceinline__ f32x16 qk_img(const LAS unsigned char* kimg, int row0, int kap, int hi, const bf16x8 (&qr)[4]) {
    const LAS unsigned char* kp = kimg + (row0 + kap) * IMG_PITCH + hi * 16; f32x16 p = {};
#pragma unroll
    for (int s = 0; s < 4; ++s) p = mfma32(*(const LAS bf16x8*)(kp + 32 * s), qr[s], p);
    return p;
}
__device__ __forceinline__ void pv_img(f32x16 (&o)[2], const LAS unsigned char* vimg, int row0, int vlane, const bf16x8 (&pb)[2]) {
    const LAS unsigned char* vp = vimg + row0 * IMG_PITCH + vlane;
#pragma unroll
    for (int db = 0; db < 2; ++db)
#pragma unroll
        for (int m = 0; m < 2; ++m) { const v4i16_t lo = vtr(vp + (8 * m) * IMG_PITCH + 64 * db), hi4 = vtr(vp + (8 * m + 4) * IMG_PITCH + 64 * db);
            const bf16x8 vf = (bf16x8){lo[0], lo[1], lo[2], lo[3], hi4[0], hi4[1], hi4[2], hi4[3]}; o[db] = mfma32(vf, pb[m], o[db]); }
}
__device__ __forceinline__ void pack_p(bf16x8 (&pb)[2], const float (&a)[16]) {
#pragma unroll
    for (int m = 0; m < 2; ++m) { u32x4 w; w.x = cvt_pk_bf16(a[8 * m], a[8 * m + 1]); w.y = cvt_pk_bf16(a[8 * m + 2], a[8 * m + 3]); w.z = cvt_pk_bf16(a[8 * m + 4], a[8 * m + 5]); w.w = cvt_pk_bf16(a[8 * m + 6], a[8 * m + 7]);
        pb[m] = __builtin_bit_cast(bf16x8, w); }
}
template <int NCH, int NROWS> __device__ __forceinline__ void img_issue(u32x4 (&pre)[NCH], const bf16* kbase, const bf16* vbase, int s0, int tid) {
#pragma unroll
    for (int i = 0; i < NCH; ++i) { const int c = tid + 512 * i, mat = c >= NROWS * 8, rem = c - mat * NROWS * 8, row = rem >> 3, ch = rem & 7;
        if (s0 + row >= 0) pre[i] = *(const u32x4*)((mat ? vbase : kbase) + (long)(s0 + row) * 64 + 8 * ch); }
}
template <int NCH, int NROWS> __device__ __forceinline__ void img_write(const u32x4 (&pre)[NCH], LAS unsigned char* img, int s0, int tid) {
#pragma unroll
    for (int i = 0; i < NCH; ++i) { const int c = tid + 512 * i, mat = c >= NROWS * 8, rem = c - mat * NROWS * 8, row = rem >> 3, ch = rem & 7;
        if (s0 + row >= 0) *(LAS u32x4*)(img + mat * NROWS * IMG_PITCH + row * IMG_PITCH + ch * 16) = pre[i]; }
}

constexpr int SWA_ROWS = 160;
__device__ __forceinline__ void swa_phase(Frame& F) {
    const bf16* QKV = (const bf16*)(F.ws + WS_QKV); bf16* O = (bf16*)(F.ws + WS_O); float* ssq = (float*)(F.ws + WS_SSQ);
    const int tid = F.tid, lane = F.lane, r32 = lane & 31, hi = lane >> 5, g = F.wave;
    const int kap = 16 * ((r32 >> 2) & 1) + (r32 & 3) + 4 * (r32 >> 3);
    const int vlane = (16 * hi + ((lane & 15) >> 2)) * IMG_PITCH + (16 * ((lane >> 4) & 1) + 4 * (lane & 3)) * 2;
    LAS unsigned char* kimg = F.lds; LAS unsigned char* vimg = F.lds + SWA_ROWS * IMG_PITCH;
    LAS float* tbl = (LAS float*)(F.lds + 2 * SWA_ROWS * IMG_PITCH) + g * 192;
    const LAS float* tbq = tbl + (r32 - 16 * hi + 17);
    u32x4 pre[5]; bf16x8 qn[4];
    int u = F.vcu; int hq_tbl = -1; float sink2 = 0.f;
    if (u < 2048) { const int b = u >> 7, kv = (u >> 6) & 1, qt = u & 63;
        img_issue<5, SWA_ROWS>(pre, qh_base(QKV, 16 + kv, b), qh_base(QKV, 18 + kv, b), 32 * (qt - 4), tid);
        const bf16* qp = qh_base(QKV, kv * 8 + g, b) + (size_t)(qt * 32 + r32) * 64 + 8 * hi;
#pragma unroll
        for (int s = 0; s < 4; ++s) qn[s] = *(const bf16x8*)(qp + 16 * s); }
    for (; u < 2048; u += F.G) {
        const int b = u >> 7, kv = (u >> 6) & 1, qt = u & 63, hq = kv * 8 + g; const size_t rowb = (size_t)b * SEQ; const int t0 = qt * 32;
        const int j0 = qt >= 4 ? 0 : 4 - qt;
        bf16x8 qr[4];
#pragma unroll
        for (int s = 0; s < 4; ++s) qr[s] = qn[s];
        if (hq != hq_tbl) {
#pragma unroll
            for (int i = 0; i < 3; ++i) { const int n = lane + 64 * i - 32; int bk = n; float tv = 0.f;
                if (n >= 0 && n < 128) { if (n >= 16) { bk = 16 + (int)(logf((float)n * (1.f / 16.f)) / logf(8.f) * 16.f); bk = bk > 31 ? 31 : bk; } tv = IN_rel_bias[bk * 16 + hq] * LOG2E; }
                tbl[n + 32] = tv; }
            sink2 = IN_sinks[hq] * LOG2E; hq_tbl = hq;
        }
        WG_BAR();
        img_write<5, SWA_ROWS>(pre, kimg, 32 * (qt - 4), tid);
        WG_BAR();
        { const int un = u + F.G; if (un < 2048) { const int bn = un >> 7, kvn = (un >> 6) & 1, qtn = un & 63;
            img_issue<5, SWA_ROWS>(pre, qh_base(QKV, 16 + kvn, bn), qh_base(QKV, 18 + kvn, bn), 32 * (qtn - 4), tid);
            const bf16* qp = qh_base(QKV, kvn * 8 + g, bn) + (size_t)(qtn * 32 + r32) * 64 + 8 * hi;
#pragma unroll
            for (int s = 0; s < 4; ++s) qn[s] = *(const bf16x8*)(qp + 16 * s); } }
        f32x16 st[5]; float mx = sink2;
#pragma unroll
        for (int j = 0; j < 5; ++j) {
            if (j < j0) {
#pragma unroll
                for (int r = 0; r < 16; ++r) st[j][r] = -1e30f;
            } else {
                f32x16 p;
#pragma unroll
                for (int r = 0; r < 16; ++r) p[r] = tbq[32 * (4 - j) + 15 - r];
                { const LAS unsigned char* kp = kimg + (32 * j + kap) * IMG_PITCH + hi * 16;
#pragma unroll
                  for (int s = 0; s < 4; ++s) p = mfma32(*(const LAS bf16x8*)(kp + 32 * s), qr[s], p); }
                if (j == 0) {
#pragma unroll
                    for (int r = 0; r < 16; ++r) p[r] = (r >= r32 - 16 * hi + 1) ? p[r] : -1e30f;
                }
                if (j == 4) {
#pragma unroll
                    for (int r = 0; r < 16; ++r) p[r] = (r <= r32 - 16 * hi) ? p[r] : -1e30f;
                }
#pragma unroll
                for (int r = 0; r < 16; ++r) mx = fmaxf(mx, p[r]);
                st[j] = p;
            } }
        mx = fmaxf(mx, __shfl_xor(mx, 32));
        float den = 0.f;
#pragma unroll
        for (int j = 0; j < 5; ++j)
#pragma unroll
            for (int r = 0; r < 16; ++r) { const float e = __builtin_amdgcn_exp2f(st[j][r] - mx); st[j][r] = e; den += e; }
        den += __shfl_xor(den, 32); den += __builtin_amdgcn_exp2f(sink2 - mx);
        f32x16 o[2]; o[0] = (f32x16){}; o[1] = (f32x16){};
#pragma unroll
        for (int j = 0; j < 5; ++j) {
            if (j >= j0) { bf16x8 pb[2]; float a[16];
#pragma unroll
                for (int r = 0; r < 16; ++r) a[r] = st[j][r];
                pack_p(pb, a); pv_img(o, vimg, 32 * j, vlane, pb); } }
        float ss = o_store(o, 1.f / den, O + ((size_t)(b * 32 + hq) * SEQ + t0 + r32) * 64, hi);
        ss += __shfl_xor(ss, 32);
        if (hi == 0) ssq[(rowb + t0 + r32) * 32 + hq] = ss;
    }
    WG_BAR();
}

constexpr int SB_ROWS = 352, SB_BELOW = 3;
constexpr float SB_CUT = 5.421010862427522e-20f;
__device__ __forceinline__ void sb_tile_math(f32x16 p, bool diag, int r32, int hi, float& C, bf16x8 (&pb)[2]) {
    float rr[16], be[16];
#pragma unroll
    for (int r = 0; r < 16; ++r) { const float e = __builtin_amdgcn_exp2f(p[r]); const float q = __builtin_amdgcn_rcpf(1.f + e); rr[r] = q; be[r] = 1.f - q; }
    if (diag) {
#pragma unroll
        for (int r = 0; r < 16; ++r) if (16 * hi + r >= r32) { rr[r] = 1.f; be[r] = 0.f; }
    }
    float run = 1.f, a[16];
#pragma unroll
    for (int r = 15; r >= 0; --r) { a[r] = be[r] * run; run *= rr[r]; }
    const float other = __shfl_xor(run, 32);
    const float base = hi ? C : C * other;
    C = C * run * other; C = C < SB_CUT ? 0.f : C;
#pragma unroll
    for (int r = 0; r < 16; ++r) a[r] *= base;
    pack_p(pb, a);
}
__device__ __forceinline__ void sb_tail(f32x16 (&o)[2], float& C, int kt, const bf16* KH, const bf16* VH, const bf16x8 (&qr)[4], LAS unsigned char* wl, int lane) {
    const int r32 = lane & 31, hi = lane >> 5; const int kap = 16 * ((r32 >> 2) & 1) + (r32 & 3) + 4 * (r32 >> 3);
    for (; kt >= 0; --kt) {
        const bf16* kp = KH + (size_t)(kt * 32 + kap) * 64 + 8 * hi; bf16x8 kf[4];
#pragma unroll
        for (int s = 0; s < 4; ++s) kf[s] = *(const bf16x8*)(kp + 16 * s);
        bf16x8 vv[4];
        { const bf16* vp = VH + (size_t)(kt * 32 + (lane & 31)) * 64 + 8 * (lane >> 5);
#pragma unroll
          for (int i = 0; i < 4; ++i) vv[i] = *(const bf16x8*)(vp + 16 * i); }
        f32x16 p = {};
#pragma unroll
        for (int s = 0; s < 4; ++s) p = mfma32(kf[s], qr[s], p);
        bf16x8 pb[2]; sb_tile_math(p, false, r32, hi, C, pb);
        vt_store(wl, vv, lane); LDS_WAIT();
        pv_tile(o, wl, pb, r32, hi); LDS_WAIT();
        if (__all(C == 0.f)) break;
    }
}
__device__ __forceinline__ void sb_phase(Frame& F) {
    const bf16* QKV = (const bf16*)(F.ws + WS_QKV); bf16* O = (bf16*)(F.ws + WS_O); float* ssq = (float*)(F.ws + WS_SSQ);
    const int tid = F.tid, lane = F.lane, r32 = lane & 31, hi = lane >> 5, w = F.wave;
    const int kap = 16 * ((r32 >> 2) & 1) + (r32 & 3) + 4 * (r32 >> 3);
    const int vlane = (16 * hi + ((lane & 15) >> 2)) * IMG_PITCH + (16 * ((lane >> 4) & 1) + 4 * (lane & 3)) * 2;
    LAS unsigned char* kimg = F.lds; LAS unsigned char* vimg = F.lds + SB_ROWS * IMG_PITCH;
    u32x4 pre[11]; bf16x8 qn[4];
    int u = F.vcu;
    if (u < 2048) { const int b = u >> 7, h = (u >> 3) & 15, qg = u & 7;
        img_issue<11, SB_ROWS>(pre, qh_base(QKV, 36 + h, b), qh_base(QKV, 52 + h, b), 32 * (8 * qg - SB_BELOW), tid);
        const bf16* qp = qh_base(QKV, 20 + h, b) + (size_t)((8 * qg + w) * 32 + r32) * 64 + 8 * hi;
#pragma unroll
        for (int s = 0; s < 4; ++s) qn[s] = *(const bf16x8*)(qp + 16 * s); }
    for (; u < 2048; u += F.G) {
        const int b = u >> 7, h = (u >> 3) & 15, qg = u & 7, qt = 8 * qg + w; const size_t rowb = (size_t)b * SEQ; const int t0 = qt * 32;
        const int tb = 8 * qg - SB_BELOW;
        bf16x8 qr[4];
#pragma unroll
        for (int s = 0; s < 4; ++s) qr[s] = qn[s];
        WG_BAR();
        img_write<11, SB_ROWS>(pre, kimg, 32 * tb, tid);
        WG_BAR();
        { const int un = u + F.G; if (un < 2048) { const int bn = un >> 7, hn = (un >> 3) & 15, qgn = un & 7;
            img_issue<11, SB_ROWS>(pre, qh_base(QKV, 36 + hn, bn), qh_base(QKV, 52 + hn, bn), 32 * (8 * qgn - SB_BELOW), tid);
            const bf16* qp = qh_base(QKV, 20 + hn, bn) + (size_t)((8 * qgn + w) * 32 + r32) * 64 + 8 * hi;
#pragma unroll
            for (int s = 0; s < 4; ++s) qn[s] = *(const bf16x8*)(qp + 16 * s); } }
        f32x16 o[2]; o[0] = (f32x16){}; o[1] = (f32x16){};
        float C = 1.f;
        const int kt_lo = tb > 0 ? tb : 0; int kt = qt;
        for (; kt >= kt_lo; --kt) {
            const f32x16 p = qk_img(kimg, 32 * (kt - tb), kap, hi, qr);
            bf16x8 pb[2]; sb_tile_math(p, kt == qt, r32, hi, C, pb);
            pv_img(o, vimg, 32 * (kt - tb), vlane, pb);
            if (__all(C == 0.f)) { kt = -1; break; }
        }
        WG_BAR();
        if (kt >= 0) sb_tail(o, C, kt, qh_base(QKV, 36 + h, b), qh_base(QKV, 52 + h, b), qr, F.lds + w * 8192, lane);
        float ss = o_store(o, 1.f, O + ((size_t)(b * 32 + 16 + h) * SEQ + t0 + r32) * 64, hi);
        ss += __shfl_xor(ss, 32);
        if (hi == 0) ssq[(rowb + t0 + r32) * 32 + 16 + h] = ss;
    }
    WG_BAR();
}

__device__ __forceinline__ void p3_attention(Frame& F) {
    swa_phase(F);
    sb_phase(F);
}

__device__ __forceinline__ void p5_router(Frame& F) {
    const float* mod = (const float*)(F.ws + WS_MOD); const float* stats = (const float*)(F.ws + WS_STATS); bf16* H = (bf16*)(F.ws + WS_H);
    const bf16* wrh = (const bf16*)(F.ws + WS_WR); const bf16* wrl = wrh + 48 * 2048;
    int* pair_e = (int*)(F.ws + WS_PAIR); int* pair_pos = pair_e + TOK * 2; float* pair_g = (float*)(pair_pos + TOK * 2); float* rowstat = pair_g + TOK * 2; int* list = (int*)(F.ws + WS_LIST);
    LAS float* A2 = (LAS float*)F.lds; LAS float* B2 = A2 + 2048;
    LAS unsigned char* wch = F.lds + 16384;
    LAS float* lg = (LAS float*)(F.lds + 16384 + 2 * 48 * 528 + 512) + F.wave * 768;
    LAS int* wcnt = (LAS int*)(F.lds + 16384 + 2 * 48 * 528 + 512 + 8 * 3072); LAS int* wbase = wcnt + 32;
    LAS int* rowe = wbase + 32; LAS float* rowg = (LAS float*)(rowe + 256); LAS int* rowrank = (LAS int*)(rowg + 256);
    const int lane = F.lane, row16 = lane & 15, kq = lane >> 4;
    for (int blk = F.vcu; blk < 256; blk += F.G) {
        const int b = blk >> 4;
        for (int k = F.tid; k < 2048; k += 512) { const float s2 = 1.f + mod[b * 12288 + 8192 + k]; A2[k] = IN_ln1_g[k] * s2; B2[k] = IN_ln1_b[k] * s2 + mod[b * 12288 + 6144 + k]; }
        if (F.tid < 32) wcnt[F.tid] = 0;
        __syncthreads();
        const size_t row = (size_t)blk * 128 + F.wave * 16 + row16;
        float mean, rstd;
        { float s = 0.f, q = 0.f; const f32x2* sp = (const f32x2*)(stats + row * 64) + kq * 8;
#pragma unroll
          for (int i = 0; i < 8; ++i) { const f32x2 v = sp[i]; s += v.x; q += v.y; }
          s += __shfl_xor(s, 16); s += __shfl_xor(s, 32); q += __shfl_xor(q, 16); q += __shfl_xor(q, 32);
          mean = s * (1.f / DM); const float var = fmaxf(q * (1.f / DM) - mean * mean, 0.f); rstd = 1.f / sqrtf(var + LN_EPS);
          if (kq == 0) *(f32x2*)(rowstat + row * 2) = (f32x2){mean, rstd}; }
        f32x4 acc[3]; acc[0] = (f32x4){0.f, 0.f, 0.f, 0.f}; acc[1] = acc[0]; acc[2] = acc[0];
        const bf16* yrow = (const bf16*)(F.ws + WS_Y1) + row * DM + 8 * kq; unsigned char* hrow = (unsigned char*)H + row * DM + 8 * kq;
        u32x4 wpre[6];
#define P5_WISSUE(kc) do { _Pragma("unroll") for (int i = 0; i < 6; ++i) { const int c = F.tid + 512 * i, mat = c >= 1536, rem = c - mat * 1536, wrow = rem >> 5, ch = rem & 31; \
            wpre[i] = *(const u32x4*)((mat ? wrl : wrh) + (size_t)wrow * 2048 + (kc) + 8 * ch); } } while (0)
#define P5_WWRITE() do { _Pragma("unroll") for (int i = 0; i < 6; ++i) { const int c = F.tid + 512 * i, mat = c >= 1536, rem = c - mat * 1536, wrow = rem >> 5, ch = rem & 31; \
            *(LAS u32x4*)(wch + mat * (48 * 528) + wrow * 528 + ch * 16) = wpre[i]; } } while (0)
        P5_WISSUE(0);
        const LAS unsigned char* bfrag = wch + row16 * 528 + kq * 16;
        u32x4 yc[8], yn[8];
#pragma unroll
        for (int st = 0; st < 8; ++st) yn[st] = *(const u32x4*)(yrow + 32 * st);
        for (int kc = 0; kc < 2048; kc += 256) {
            WG_BAR();
            P5_WWRITE();
            WG_BAR();
#pragma unroll
            for (int st = 0; st < 8; ++st) yc[st] = yn[st];
            if (kc + 256 < 2048) { P5_WISSUE(kc + 256);
#pragma unroll
                for (int st = 0; st < 8; ++st) yn[st] = *(const u32x4*)(yrow + kc + 256 + 32 * st); }
#pragma unroll
            for (int st = 0; st < 8; ++st) { const int k0 = kc + 32 * st;
                const u32x4 yw = yc[st]; const f32x4 y0 = (f32x4){bf_lo(yw.x), bf_hi(yw.x), bf_lo(yw.y), bf_hi(yw.y)}, y1v = (f32x4){bf_lo(yw.z), bf_hi(yw.z), bf_lo(yw.w), bf_hi(yw.w)};
                const f32x4 a0 = *(const LAS f32x4*)(A2 + k0 + 8 * kq), a1 = *(const LAS f32x4*)(A2 + k0 + 8 * kq + 4), b0 = *(const LAS f32x4*)(B2 + k0 + 8 * kq), b1 = *(const LAS f32x4*)(B2 + k0 + 8 * kq + 4);
                const f32x4 h0 = (y0 - mean) * rstd * a0 + b0, h1 = (y1v - mean) * rstd * a1 + b1;
                u32x4 ph; ph.x = cvt_pk_bf16(h0[0], h0[1]); ph.y = cvt_pk_bf16(h0[2], h0[3]); ph.z = cvt_pk_bf16(h1[0], h1[1]); ph.w = cvt_pk_bf16(h1[2], h1[3]);
                { u32x2 h8; h8.x = cvt_fp8x4(h0[0], h0[1], h0[2], h0[3]); h8.y = cvt_fp8x4(h1[0], h1[1], h1[2], h1[3]); *(u32x2*)(hrow + k0) = h8; }
                u32x4 pl; pl.x = cvt_pk_bf16(h0[0] - bf_lo(ph.x), h0[1] - bf_hi(ph.x)); pl.y = cvt_pk_bf16(h0[2] - bf_lo(ph.y), h0[3] - bf_hi(ph.y));
                pl.z = cvt_pk_bf16(h1[0] - bf_lo(ph.z), h1[1] - bf_hi(ph.z)); pl.w = cvt_pk_bf16(h1[2] - bf_lo(ph.w), h1[3] - bf_hi(ph.w));
                const bf16x8 ah = __builtin_bit_cast(bf16x8, ph), al = __builtin_bit_cast(bf16x8, pl);
                bf16x8 wh[3], wl2[3];
#pragma unroll
                for (int cg = 0; cg < 3; ++cg) { wh[cg] = *(const LAS bf16x8*)(bfrag + cg * 16 * 528 + st * 64); wl2[cg] = *(const LAS bf16x8*)(bfrag + 48 * 528 + cg * 16 * 528 + st * 64); }
#pragma unroll
                for (int cg = 0; cg < 3; ++cg) acc[cg] = __builtin_amdgcn_mfma_f32_16x16x32_bf16(ah, wh[cg], acc[cg], 0, 0, 0);
#pragma unroll
                for (int cg = 0; cg < 3; ++cg) acc[cg] = __builtin_amdgcn_mfma_f32_16x16x32_bf16(al, wh[cg], acc[cg], 0, 0, 0);
#pragma unroll
                for (int cg = 0; cg < 3; ++cg) acc[cg] = __builtin_amdgcn_mfma_f32_16x16x32_bf16(ah, wl2[cg], acc[cg], 0, 0, 0); }
        }
#undef P5_WISSUE
#undef P5_WWRITE
#pragma unroll
        for (int cg = 0; cg < 3; ++cg)
#pragma unroll
            for (int i = 0; i < 4; ++i) lg[(4 * kq + i) * 48 + 16 * cg + row16] = acc[cg][i];
        LDS_WAIT();
        if (lane < 16) {
            const LAS float* l = lg + lane * 48; float gl[4];
#pragma unroll
            for (int j = 0; j < 4; ++j) gl[j] = l[j] + IN_b_grp[j];
            int gs = 0; float gm = gl[0];
#pragma unroll
            for (int j = 1; j < 4; ++j) if (gl[j] > gm) { gm = gl[j]; gs = j; }
            float gsum = 0.f;
#pragma unroll
            for (int j = 0; j < 4; ++j) gsum += expf(gl[j] - gm);
            const float pg = 1.f / gsum;
            float v0 = -INFINITY, v1 = -INFINITY; int i0 = 0, i1 = 0;
            for (int j = 0; j < 8; ++j) { const float v = l[4 + 8 * gs + j] + IN_b_rtr[8 * gs + j];
                if (v > v0) { v1 = v0; i1 = i0; v0 = v; i0 = j; } else if (v > v1) { v1 = v; i1 = j; } }
            const float e1 = expf(v1 - v0), inv = 1.f / (1.f + e1);
            const int lr = F.wave * 16 + lane;
            rowe[2 * lr] = 8 * gs + i0; rowe[2 * lr + 1] = 8 * gs + i1; rowg[2 * lr] = pg * inv; rowg[2 * lr + 1] = pg * e1 * inv;
        }
        __syncthreads();
        if (F.tid < 256) rowrank[F.tid] = __hip_atomic_fetch_add(wcnt + rowe[F.tid], 1, __ATOMIC_RELAXED, __HIP_MEMORY_SCOPE_WORKGROUP);
        __syncthreads();
        if (F.tid < 32) wbase[F.tid] = (int)__hip_atomic_fetch_add(F.ctl + CW_CNT + 64 * F.tid, (unsigned)wcnt[F.tid], __ATOMIC_RELAXED, __HIP_MEMORY_SCOPE_AGENT);
        __syncthreads();
        if (F.tid < 256) { const int e = rowe[F.tid], pos = wbase[e] + rowrank[F.tid]; const int tok = blk * 128 + (F.tid >> 1); const size_t pi = (size_t)tok * 2 + (F.tid & 1);
            pair_e[pi] = e; pair_pos[pi] = pos; pair_g[pi] = rowg[F.tid]; list[(size_t)e * LCAP + pos] = tok; }
        __syncthreads();
    }
}

__device__ __forceinline__ int moe_tables(Frame& F) {
    LAS int* tst = (LAS int*)(F.lds + TBL_OFF); LAS int* cnt = tst + 40;
    if (F.tid < 32) cnt[F.tid] = (int)__hip_atomic_load(F.ctl + CW_CNT + 64 * F.tid, __ATOMIC_RELAXED, __HIP_MEMORY_SCOPE_AGENT);
    __syncthreads();
    if (F.tid == 0) { int s = 0; for (int e = 0; e < 32; ++e) { tst[e] = s; s += (cnt[e] + 255) >> 8; } tst[32] = s; }
    __syncthreads();
    if (F.tid < MAXTILES) { int e = 0; while (e < 31 && tst[e + 1] <= F.tid) ++e; ((LAS int*)(F.lds + RTE_OFF))[F.tid] = e; }
    __syncthreads();
    return tst[32];
}

__device__ __forceinline__ void p8_final(Frame& F) {
    const float* mod = (const float*)(F.ws + WS_MOD); const float* stats = (const float*)(F.ws + WS_STATS); const unsigned char* YS = F.ws + WS_YS;
    const int* pair_e = (const int*)(F.ws + WS_PAIR); const int* pair_pos = pair_e + TOK * 2; const float* pair_g = (const float*)(pair_pos + TOK * 2); const float* rowstat = pair_g + TOK * 2;
    const LAS int* tst = (const LAS int*)(F.lds + TBL_OFF);
    LAS float* G1 = (LAS float*)F.lds; LAS float* B1 = G1 + 2048; LAS float* GT = B1 + 2048; LAS float* G2 = GT + 2048; LAS float* Bv2 = G2 + 2048;
    for (int blk = F.vcu; blk < 256; blk += F.G) {
        const int b = blk >> 4;
        for (int k = F.tid; k < 2048; k += 512) { G1[k] = IN_ln1_g[k]; B1[k] = IN_ln1_b[k]; GT[k] = 1.f + mod[b * 12288 + 10240 + k]; G2[k] = IN_ln2_g[k]; Bv2[k] = IN_ln2_b[k]; }
        __syncthreads();
        for (int r = F.wave; r < 128; r += 16) {
            float mean[2], rstd[2], g0[2], g1[2]; size_t s0[2], s1[2]; f32x4 v[2][8]; float sum[2];
#pragma unroll
            for (int q = 0; q < 2; ++q) { const size_t row = (size_t)blk * 128 + r + 8 * q;
                mean[q] = rowstat[row * 2]; rstd[q] = rowstat[row * 2 + 1];
                const int e0 = pair_e[row * 2], e1 = pair_e[row * 2 + 1]; g0[q] = pair_g[row * 2] * (1.f / YS_SCALE); g1[q] = pair_g[row * 2 + 1] * (1.f / YS_SCALE);
                s0[q] = (size_t)tst[e0] * 256 + pair_pos[row * 2]; s1[q] = (size_t)tst[e1] * 256 + pair_pos[row * 2 + 1]; }
            u32x2 yw[2][8]; unsigned ya[2][8], yb[2][8];
#pragma unroll
            for (int q = 0; q < 2; ++q) { const size_t row = (size_t)blk * 128 + r + 8 * q;
#pragma unroll
                for (int j = 0; j < 8; ++j) { const int col = 4 * F.lane + 256 * j; yw[q][j] = *(const u32x2*)((const bf16*)(F.ws + WS_Y1) + row * DM + col);
                    ya[q][j] = *(const unsigned*)(YS + s0[q] * DM + col); yb[q][j] = *(const unsigned*)(YS + s1[q] * DM + col); } }
            asm volatile("" ::: "memory");
#pragma unroll
            for (int q = 0; q < 2; ++q) { sum[q] = 0.f;
#pragma unroll
                for (int j = 0; j < 8; ++j) { const int col = 4 * F.lane + 256 * j; const f32x4 y = (f32x4){bf_lo(yw[q][j].x), bf_hi(yw[q][j].x), bf_lo(yw[q][j].y), bf_hi(yw[q][j].y)};
                    const f32x2 al = __builtin_amdgcn_cvt_pk_f32_fp8((int)ya[q][j], false), ah = __builtin_amdgcn_cvt_pk_f32_fp8((int)ya[q][j], true), bl = __builtin_amdgcn_cvt_pk_f32_fp8((int)yb[q][j], false), bh = __builtin_amdgcn_cvt_pk_f32_fp8((int)yb[q][j], true);
                    const f32x4 fa = (f32x4){al.x, al.y, ah.x, ah.y}, fb = (f32x4){bl.x, bl.y, bh.x, bh.y};
                    const f32x4 x1 = (y - mean[q]) * rstd[q] * *(const LAS f32x4*)(G1 + col) + *(const LAS f32x4*)(B1 + col);
                    v[q][j] = x1 * ALPHA_DN + *(const LAS f32x4*)(GT + col) * (fa * g0[q] + fb * g1[q]); sum[q] += (v[q][j][0] + v[q][j][1]) + (v[q][j][2] + v[q][j][3]);
                    if (j & 1) asm volatile("" ::: "memory"); } }
            float m2[2], sq[2], r2[2];
#pragma unroll
            for (int q = 0; q < 2; ++q) { m2[q] = wave_sum(sum[q]) * (1.f / DM); sq[q] = 0.f;
#pragma unroll
                for (int j = 0; j < 8; ++j) { v[q][j] = v[q][j] - m2[q]; sq[q] += (v[q][j][0] * v[q][j][0] + v[q][j][1] * v[q][j][1]) + (v[q][j][2] * v[q][j][2] + v[q][j][3] * v[q][j][3]); } }
#pragma unroll
            for (int q = 0; q < 2; ++q) { const size_t row = (size_t)blk * 128 + r + 8 * q; r2[q] = 1.f / sqrtf(wave_sum(sq[q]) * (1.f / DM) + LN_EPS);
#pragma unroll
                for (int j = 0; j < 8; ++j) { const int col = 4 * F.lane + 256 * j; __builtin_nontemporal_store(v[q][j] * r2[q] * *(const LAS f32x4*)(G2 + col) + *(const LAS f32x4*)(Bv2 + col), (f32x4*)(F.out + row * DM + col)); } } }
        __syncthreads();
    }
}

struct Args { const float* in[21]; float* out; unsigned char* ws; };
__global__ void __launch_bounds__(512, 2) hybrid_fwd(Args args) {
    extern __shared__ __attribute__((aligned(16))) unsigned char lds[];
    Frame F;
    F.lds = (LAS unsigned char*)lds;
    F.tid = threadIdx.x; F.lane = F.tid & 63; F.wave = __builtin_amdgcn_readfirstlane(F.tid >> 6);
    F.G = gridDim.x; { const int bx = blockIdx.x; F.vcu = (F.G % 8 == 0) ? (bx % 8) * (F.G / 8) + bx / 8 : bx; }
    F.ws = args.ws; F.out = args.out; F.ctl = (unsigned*)(args.ws + WS_CTL);
    F.in = args.in;
    volatile LAS unsigned* MISC = (volatile LAS unsigned*)(F.lds + MISC_OFF);
    if (F.tid < 32) MISC[F.tid] = 0u;
    __syncthreads();
    XcdBarrier bar = xcd_barrier_post(F.ctl + CW_BAR, MISC + 8);

#ifndef PHMASK
#define PHMASK 0x1ff
#endif
#ifndef REPMASK
#define REPMASK 0
#endif
#define REFRESH() do { int t_ = threadIdx.x; asm volatile("" : "+v"(t_)); F.tid = t_; F.lane = t_ & 63; } while (0)
#define PH(n) if constexpr (((PHMASK) >> (n)) & 1) _Pragma("nounroll") for (int rep_ = 0; rep_ < 1 + (((REPMASK) >> (n)) & 1); ++rep_, __syncthreads())
    REFRESH();
    PH(0) p0_prologue(F);
    xcd_barrier(bar);
    REFRESH();
    PH(1) p1_modulate(F);
    xcd_barrier(bar);
    REFRESH();
    PH(2) { pg8::Gemm g{(const bf16*)(F.ws + WS_H), (const bf16*)(F.ws + WS_WIN), DM, 0}; pg8::StaticOrder S; S.init(TOK, QKVD, F.G, (int)blockIdx.x);
      EpiStoreBf16 E{(bf16*)(F.ws + WS_QKV), QKVD, 1.f};
      cvt8_deferred2(F, 0); __syncthreads();
      pg8::gemm_phase<EpiStoreBf16, pg8::StaticOrder, false, false>(F.lds, g, S, E);
      cvt8_deferred2(F, 1); }
    xcd_barrier(bar);
    REFRESH();
    PH(3) p3_attention(F);
    xcd_barrier(bar);
    REFRESH();
    PH(4) { pg8::Gemm g{(const bf16*)(F.ws + WS_O), (const bf16*)(F.ws + WS_WOUT), DM, 0}; pg8::StaticOrder S; S.init(TOK, DM, F.G, (int)blockIdx.x);
      cvt8_deferred4(F);
      LAS float* rsL = (LAS float*)(F.lds + RS_OFF); const float* ssq = (const float*)(F.ws + WS_SSQ);
      { pg8::Unit u;
        for (int i = 0; i < 4 && S.next(i, u); ++i) if (F.tid < 256) { const f32x4* sp = (const f32x4*)(ssq + (size_t)(u.pm * 256 + F.tid) * 32); float sa = 0.f, sb = 0.f;
#pragma unroll
            for (int j = 0; j < 4; ++j) { const f32x4 va = sp[j], vb = sp[4 + j]; sa += (va[0] + va[1]) + (va[2] + va[3]); sb += (vb[0] + vb[1]) + (vb[2] + vb[3]); }
            const float ra = 1.f / sqrtf(sa * (1.f / 1024.f) + LN_EPS), rb = 1.f / sqrtf(sb * (1.f / 1024.f) + LN_EPS);
            rsL[(i * 256 + F.tid) * 2] = ra / rb; rsL[(i * 256 + F.tid) * 2 + 1] = rb; } }
      __syncthreads();
      EpiOutProj E{(const bf16*)(F.ws + WS_H), (const float*)(F.ws + WS_P4TAB), rsL, (bf16*)(F.ws + WS_Y1), (float*)(F.ws + WS_STATS)};
      pg8::gemm_phase<EpiOutProj, pg8::StaticOrder, false, true, false, true>(F.lds, g, S, E); }
    xcd_barrier(bar);
    REFRESH();
    PH(5) p5_router(F);
    xcd_barrier(bar);
    REFRESH();
    const int NT = moe_tables(F);
    REFRESH();
    PH(6) { pg8::Gemm g{(const bf16*)(F.ws + WS_H), (const bf16*)(F.ws + WS_WGU), DM / 2, (size_t)1024 * DM};
      MoeOrder S{(const LAS int*)(F.lds + TBL_OFF), (const LAS int*)(F.lds + TBL_OFF) + 40, (const int*)(F.ws + WS_LIST), 4, F.G, F.vcu, NT, (const LAS unsigned*)(F.lds + RS_OFF), (const LAS int*)(F.lds + RTE_OFF), 0};
      S.fill_rowtab((LAS unsigned*)(F.lds + RS_OFF), F.tid); __syncthreads();
      EpiSwiGLU E{F.ws + WS_ACT};
      pg8::gemm_phase<EpiSwiGLU, MoeOrder, true, false, true>(F.lds, g, S, E);
      cvt8_deferred6(F, NT * 4); }
    xcd_barrier(bar);
    REFRESH();
    PH(7) { pg8::Gemm g{(const bf16*)(F.ws + WS_ACT), (const bf16*)(F.ws + WS_WDN), DEXP / 2, (size_t)DM * DEXP};
      MoeOrder S{(const LAS int*)(F.lds + TBL_OFF), (const LAS int*)(F.lds + TBL_OFF) + 40, (const int*)(F.ws + WS_LIST), 8, F.G, F.vcu, NT, (const LAS unsigned*)(F.lds + RS_OFF), (const LAS int*)(F.lds + RTE_OFF), 0};
      EpiStoreFp8 E{F.ws + WS_YS, DM, YS_SCALE / (ACT_SCALE * W_DN_SCALE)};
      pg8::gemm_phase<EpiStoreFp8, MoeOrder, false, false, true>(F.lds, g, S, E); }
    xcd_barrier(bar);
    REFRESH();
    PH(8) p8_final(F);
}

extern "C" void kernel_launch(void* const* d_in, const int* in_sizes, int n_in, void* d_out, int out_size, void* d_ws, size_t ws_size, hipStream_t stream) {
    static int grid = 0;
    if (grid == 0) {
        if (n_in != 21 || out_size != TOK * DM || ws_size < WS_END) { fprintf(stderr, "kernel_launch: unexpected problem shape (n_in %d, out %d, ws %zu)\n", n_in, out_size, ws_size); grid = -1; return; }
        int dev = 0, cus = 0, per_cu = 0;
        if (hipGetDevice(&dev) != hipSuccess || hipDeviceGetAttribute(&cus, hipDeviceAttributeMultiprocessorCount, dev) != hipSuccess) { grid = -1; return; }
        if (hipFuncSetAttribute((const void*)hybrid_fwd, hipFuncAttributeMaxDynamicSharedMemorySize, LDS_BYTES) != hipSuccess) { fprintf(stderr, "kernel_launch: hipFuncSetAttribute failed\n"); grid = -1; return; }
        if (hipOccupancyMaxActiveBlocksPerMultiprocessor(&per_cu, (const void*)hybrid_fwd, 512, LDS_BYTES) != hipSuccess || per_cu < 1) { fprintf(stderr, "kernel_launch: occupancy query reports %d\n", per_cu); }
        (void)hipGetLastError();
        grid = cus;
    }
    if (grid < 0) return;
    if (hipMemsetAsync((char*)d_ws + WS_CTL, 0, CTL_ZERO_BYTES, stream) != hipSuccess) return;
    Args a{};
    for (int i = 0; i < 21; ++i) a.in[i] = (const float*)d_in[i];
    a.out = (float*)d_out; a.ws = (unsigned char*)d_ws;
    hipLaunchKernelGGL(hybrid_fwd, dim3(grid), dim3(512), LDS_BYTES, stream, a);
}
```

```cpp
#include <hip/hip_runtime.h>
#include <cstdio>
#include <cstdint>

constexpr int TOK = 32768, DM = 2048, SEQ = 2048, NBATCH = 16, QKVD = 4352;
constexpr int NEXP = 32, DEXP = 512, LCAP = 32768;
constexpr int MAXTILES = 288, SLOTS = MAXTILES * 256;
constexpr float ALPHA_DN = 1.189207115002721f;
constexpr float LN_EPS = 1e-5f;
constexpr float LOG2E = 1.4426950408889634f;
constexpr float W_GU_SCALE = 64.f, W_DN_SCALE = 32.f, ACT_SCALE = 8.f, YS_SCALE = 16.f;
constexpr float QSCALE = 0.125f * 1.4426950408889634f;
constexpr int COL_KA = 1024, COL_VA = 1152, COL_QB = 1280, COL_KB = 2304, COL_VB = 3328;

constexpr size_t MiB = 1u << 20;
constexpr size_t WS_CTL = 0, CTL_ZERO_BYTES = 96 * 1024;
constexpr size_t WS_MOD = 1 * MiB;
constexpr size_t WS_SSQ = 894 * MiB;
constexpr size_t WS_P4TAB = 2 * MiB;
constexpr size_t WS_PAIR = 3 * MiB;
constexpr size_t WS_WR = 4 * MiB;
constexpr size_t WS_STATS = 8 * MiB;
constexpr size_t WS_LIST = 16 * MiB;
constexpr size_t WS_WIN = 20 * MiB;
constexpr size_t WS_WOUT = 38 * MiB;
constexpr size_t WS_WGU = 46 * MiB;
constexpr size_t WS_WDN = 174 * MiB;
constexpr size_t WS_H = 238 * MiB;
constexpr size_t WS_QKV = 366 * MiB;
constexpr size_t WS_O = 638 * MiB;
constexpr size_t WS_ACT = 366 * MiB;
constexpr size_t WS_YS = 438 * MiB;
constexpr size_t WS_Y1 = 766 * MiB;
constexpr size_t WS_END = 898 * MiB;
static_assert(WS_WIN + (size_t)QKVD * DM * 2 <= WS_WOUT && WS_QKV + (size_t)TOK * QKVD * 2 <= WS_O && WS_ACT + (size_t)SLOTS * DEXP * 2 <= WS_YS && WS_YS + (size_t)SLOTS * DM * 2 <= WS_Y1 && WS_Y1 + (size_t)TOK * DM * 2 <= WS_SSQ && WS_SSQ + (size_t)TOK * 32 * 4 <= WS_END, "d_ws map");
constexpr int CW_BAR = 4096;
constexpr int CW_CNT = 16384;
static_assert((CW_CNT + 64 * 32) * 4 <= (int)CTL_ZERO_BYTES && (CW_BAR + 3456) * 4 <= CW_CNT * 4, "control words inside the per-call memset");

constexpr int RING_BYTES = 131072;
constexpr int MISC_OFF = RING_BYTES + 320;
constexpr int TBL_OFF = RING_BYTES + 1024;
constexpr int RS_OFF = RING_BYTES + 2048;
constexpr int RTE_OFF = RS_OFF + 8192;
constexpr int P4TAB_OFF = 142464;
constexpr int LDS_BYTES = 147456;
static_assert(RTE_OFF + 288 * 4 <= P4TAB_OFF && P4TAB_OFF + 4096 <= LDS_BYTES, "LDS map");

#define GAS __attribute__((address_space(1)))
#define LAS __attribute__((address_space(3)))
typedef unsigned short bf16;
typedef unsigned u32x4 __attribute__((ext_vector_type(4)));
typedef unsigned u32x2 __attribute__((ext_vector_type(2)));
typedef float f32x4 __attribute__((ext_vector_type(4)));
typedef float f32x2 __attribute__((ext_vector_type(2)));
typedef float f32x16 __attribute__((ext_vector_type(16)));
typedef short bf16x8 __attribute__((ext_vector_type(8)));
#define LDS_WAIT() asm volatile("s_waitcnt lgkmcnt(0)" ::: "memory")
#define VM_WAIT() asm volatile("s_waitcnt vmcnt(0)" ::: "memory")

__device__ __forceinline__ unsigned cvt_pk_bf16(float lo, float hi) { unsigned r; asm volatile("v_cvt_pk_bf16_f32 %0, %1, %2" : "=v"(r) : "v"(lo), "v"(hi)); return r; }
__device__ __forceinline__ unsigned cvt_fp8x4(float a, float b, float c, float d) { int w = 0; w = __builtin_amdgcn_cvt_pk_fp8_f32(a, b, w, false); w = __builtin_amdgcn_cvt_pk_fp8_f32(c, d, w, true); return (unsigned)w; }
__device__ __forceinline__ float bf_lo(unsigned w) { return __uint_as_float(w << 16); }
__device__ __forceinline__ float bf_hi(unsigned w) { return __uint_as_float(w & 0xffff0000u); }
#define DPP_ADD(v, ctrl) ((v) + __builtin_bit_cast(float, __builtin_amdgcn_update_dpp(0, __builtin_bit_cast(int, (v)), (ctrl), 0xf, 0xf, true)))
__device__ __forceinline__ float wave_sum(float v) {
    v = DPP_ADD(v, 0xB1); v = DPP_ADD(v, 0x4E); v = DPP_ADD(v, 0x141); v = DPP_ADD(v, 0x140);
    v += __shfl_xor(v, 16); v += __shfl_xor(v, 32);
    return v;
}
namespace pg8 {
#define PG8_LAS __attribute__((address_space(3)))
typedef unsigned short bf16_t;
constexpr int BM = 256, BK = 64, HALF = 128, HTB = HALF * BK * 2, STAGE_BYTES = 8 * HTB, NXCD = 8, WGM = 8;
__host__ __device__ __forceinline__ int lds_byte(int r, int c) { const int st = (r >> 4) * 2 + (c >> 5), rr = r & 15, cc = c & 31, ob = rr * 64 + cc * 2; return st * 1024 + (ob ^ (((ob >> 9) & 1) << 5)); }
__host__ __device__ __forceinline__ void stage_rc(int b, int& R, int& C) { const int st = b / 1024, sb = b % 1024, swz = sb ^ (((sb >> 9) & 1) << 5); R = (st >> 1) * 16 + swz / 64; C = (st & 1) * 32 + (swz % 64) / 2; }
__host__ __device__ __forceinline__ int perm32(int rho) { const int n = rho >> 4, i = rho & 15; return 8 * (i >> 2) + 4 * n + (i & 3); }

typedef int v8i32_t __attribute__((ext_vector_type(8))); typedef int v4i32_t __attribute__((ext_vector_type(4)));
__device__ __forceinline__ v8i32_t cat8(bf16x8 lo, bf16x8 hi) { const v4i32_t a = __builtin_bit_cast(v4i32_t, lo), b = __builtin_bit_cast(v4i32_t, hi); return __builtin_shufflevector(a, b, 0, 1, 2, 3, 4, 5, 6, 7); }
struct Unit { int pm, pn, e; };
template <class T, class = void> struct pg8_tab { static constexpr bool value = false; };
template <class T> struct pg8_tab<T, decltype((void)T::TABLE)> { static constexpr bool value = T::TABLE; };
struct Gemm { const bf16_t* A; const bf16_t* Bt; int K; size_t bexp; };

struct StaticOrder {
    int nM, nN, nwg, G, c;
    __device__ __forceinline__ void init(int M, int N, int G_, int c_) { nM = M / BM; nN = N / BM; nwg = nM * nN; G = G_; c = c_; }
    __device__ __forceinline__ bool next(int i, Unit& u) const {
        const long L = (long)i * G + c; if (L >= nwg) return false;
        int wgid = (int)L; { const int q = nwg / NXCD, r = nwg % NXCD, xcd = wgid % NXCD, off = wgid / NXCD; wgid = (xcd < r ? xcd * (q + 1) : r * (q + 1) + (xcd - r) * q) + off; }
        const int nig = WGM * nN, gid = wgid / nig, fm = gid * WGM, gsz = (nM - fm) < WGM ? (nM - fm) : WGM;
        u.pm = fm + ((wgid % nig) % gsz); u.pn = (wgid % nig) / gsz; u.e = 0; return true;
    }
    __device__ __forceinline__ unsigned row_off(int, int) const { return 0u; }
};

template <class Epi, class Sched, bool GATHER, bool MIDSCALE, bool FP8 = false, bool AHM = false, bool AT = false, bool BT = false>
__device__ __forceinline__ void gemm_phase(PG8_LAS unsigned char* lds, const Gemm g, const Sched& S, const Epi& E) {
    int tid_ = threadIdx.x; asm volatile("" : "+v"(tid_));
    const int tid = tid_, wid = __builtin_amdgcn_readfirstlane(tid >> 6), lane = tid & 63, wr = wid >> 2, wc = wid & 3, fr = lane & 15, fq = lane >> 4;
    int K_ = g.K; asm volatile("" : "+s"(K_));
    const int K = K_, nt = K / BK;
    unsigned voffA[2], voffB[2], voffB16[2][2]; int RA[2]; unsigned CA2[2];
#pragma unroll
    for (int i = 0; i < 2; ++i) { int R, C; stage_rc(tid * 16 + i * 8192, R, C); const int Rb = Epi::PERM ? ((R & ~31) + perm32(R & 31)) : R;
        voffA[i] = (unsigned)(R * ((AHM || AT) ? 64 : K) + C) * 2u; voffB[i] = (unsigned)(Rb * (BT ? 64 : K) + C) * 2u; RA[i] = R; CA2[i] = (unsigned)C * 2u;
        if constexpr (Epi::PERM16) {
#pragma unroll
            for (int h = 0; h < 2; ++h) { const int g16 = 64 * (R >> 5) + 16 * ((R >> 2) & 3) + 8 * h + 4 * ((R >> 4) & 1) + (R & 3); voffB16[h][i] = (unsigned)(g16 * (BT ? 64 : K) + C) * 2u; } } }
    const size_t kstep = (size_t)(BK * 2);
    const size_t hstep = (size_t)HALF * K * 2;
    const size_t tstep = 2 * hstep;
    const size_t kstepA = AHM ? (size_t)SEQ * 64 * 2 : (AT ? (size_t)BM * 64 * 2 : kstep), hstepA = (AHM || AT) ? (size_t)HALF * 64 * 2 : hstep;
    const size_t kstepB = BT ? (size_t)BM * 64 * 2 : kstep, hstepB = BT ? (size_t)HALF * 64 * 2 : hstep;
#define PG8_ABASE(pm_) (AHM ? (const char*)g.A + ((size_t)((pm_) >> 3) * (K / 64) * SEQ + (size_t)((pm_) & 7) * 256) * 128 : (const char*)g.A + (size_t)(pm_) * tstep)
    const unsigned ldsw = (unsigned)wid * 1024u;
    const int aoff = lds_byte(wr * 64 + fr, fq * 8), boff = lds_byte(wc * 32 + fr, fq * 8);
#define PG8_SA(b, h) (((b) * 2 + (h)) * HTB)
#define PG8_SB(b, h) ((4 + (b) * 2 + (h)) * HTB)
#define PG8_STAGE(bufoff, gbase, voff) do { _Pragma("unroll") for (int _i = 0; _i < 2; ++_i) \
        __builtin_amdgcn_global_load_lds((const unsigned*)((const char*)(gbase) + (voff)[_i]), (PG8_LAS unsigned*)(lds + (bufoff) + ldsw + _i * 8192), 16, 0, 0); } while (0)
#define PG8_STB(bufoff, p, h) do { if constexpr (Epi::PERM16) { PG8_STAGE(bufoff, p, voffB16[h]); } else { PG8_STAGE(bufoff, (p) + (h) * hstepB, voffB); } } while (0)
#define PG8_STA(bufoff, p, h, OFF) do { if constexpr (GATHER) { PG8_STAGE(bufoff, p, (OFF)[h]); } else { PG8_STAGE(bufoff, (p) + (h) * hstepA, voffA); } } while (0)
#define PG8_LDA(dst, b, h) do { _Pragma("unroll") for (int m = 0; m < 4; ++m) { if constexpr (FP8) { dst##8[m] = cat8(*(const PG8_LAS bf16x8*)(lds + PG8_SA(b, h) + aoff + m * 2048), *(const PG8_LAS bf16x8*)(lds + PG8_SA(b, h) + aoff + m * 2048 + 1024)); } \
        else { _Pragma("unroll") for (int k = 0; k < 2; ++k) dst[m][k] = *(const PG8_LAS bf16x8*)(lds + PG8_SA(b, h) + aoff + m * 2048 + k * 1024); } } } while (0)
#define PG8_LDB(dst, b, h) do { _Pragma("unroll") for (int n = 0; n < 2; ++n) { if constexpr (FP8) { dst##8[n] = cat8(*(const PG8_LAS bf16x8*)(lds + PG8_SB(b, h) + boff + n * 2048), *(const PG8_LAS bf16x8*)(lds + PG8_SB(b, h) + boff + n * 2048 + 1024)); } \
        else { _Pragma("unroll") for (int k = 0; k < 2; ++k) dst[n][k] = *(const PG8_LAS bf16x8*)(lds + PG8_SB(b, h) + boff + n * 2048 + k * 1024); } } } while (0)
#define PG8_MMA(ai, bj, At, Bt) do { __builtin_amdgcn_s_setprio(1); _Pragma("unroll") for (int m = 0; m < 4; ++m) _Pragma("unroll") for (int n = 0; n < 2; ++n) { \
        if constexpr (FP8) { asm volatile("v_mfma_scale_f32_16x16x128_f8f6f4 %0, %1, %2, %0, %3, %3 op_sel_hi:[0,0,0]" : "+v"(acc[ai][bj][m][n]) : "v"(Bt##8[n]), "v"(At##8[m]), "v"(fp8_one)); } \
        else { _Pragma("unroll") for (int k = 0; k < 2; ++k) acc[ai][bj][m][n] = __builtin_amdgcn_mfma_f32_16x16x32_bf16(Bt[n][k], At[m][k], acc[ai][bj][m][n], 0, 0, 0); } } \
        __builtin_amdgcn_s_setprio(0); } while (0)
#define PG8_WAIT_V(n) asm volatile("s_waitcnt vmcnt(" #n ")" ::: "memory")
#define PG8_WAIT_V8T() do { if constexpr (pg8_tab<Epi>::value) { if (t == 2) PG8_WAIT_V(10); else PG8_WAIT_V(8); } else PG8_WAIT_V(8); } while (0)
#define PG8_WAIT_L(n) asm volatile("s_waitcnt lgkmcnt(" #n ")" ::: "memory")
#define PG8_BAR __builtin_amdgcn_s_barrier()
#define PG8_SCHED __builtin_amdgcn_sched_barrier(0)
    Unit cur, nxt; int ui = 0;
    if (!S.next(0, cur)) return;
    f32x4 acc[2][2][4][2];
#pragma unroll
    for (int a = 0; a < 2; ++a)
#pragma unroll
        for (int b = 0; b < 2; ++b)
#pragma unroll
            for (int m = 0; m < 4; ++m)
#pragma unroll
                for (int n = 0; n < 2; ++n) acc[a][b][m][n] = (f32x4){0.f, 0.f, 0.f, 0.f};
    bf16x8 At[4][2], B0[2][2], B1[2][2]; v8i32_t At8[4], B08[2], B18[2];
    const int fp8_one = 0x7F7F7F7F;
    unsigned offC[2][2], offN[2][2];
    if constexpr (GATHER) {
#pragma unroll
        for (int h = 0; h < 2; ++h)
#pragma unroll
            for (int i = 0; i < 2; ++i) { offC[h][i] = S.row_off(0, RA[i] + HALF * h) + CA2[i]; offN[h][i] = offC[h][i]; }
    }
    const char* cA = GATHER ? (const char*)g.A : PG8_ABASE(cur.pm);
    const char* cB = (const char*)g.Bt + (size_t)cur.e * g.bexp + (size_t)cur.pn * tstep;
    PG8_STB(PG8_SB(0, 0), cB, 0); PG8_STB(PG8_SB(0, 1), cB, 1); PG8_STA(PG8_SA(0, 0), cA, 0, offC); PG8_STA(PG8_SA(0, 1), cA, 1, offC);
    if (wr == 1) PG8_BAR;
    PG8_WAIT_V(2); PG8_BAR;
    PG8_STB(PG8_SB(1, 0), cB + kstepB, 0); PG8_STA(PG8_SA(1, 0), cA + kstepA, 0, offC); PG8_STB(PG8_SB(1, 1), cB + kstepB, 1);
    PG8_WAIT_V(6); PG8_BAR;
    for (;;) {
        const bool has_next = S.next(ui + 1, nxt);
        const char* nA = GATHER ? (const char*)g.A : (has_next ? PG8_ABASE(nxt.pm) : cA);
        const char* nB = has_next ? (const char*)g.Bt + (size_t)nxt.e * g.bexp + (size_t)nxt.pn * tstep : cB;
        if constexpr (GATHER) {
            if (has_next) {
#pragma unroll
                for (int h = 0; h < 2; ++h)
#pragma unroll
                    for (int i = 0; i < 2; ++i) offN[h][i] = S.row_off(ui + 1, RA[i] + HALF * h) + CA2[i];
            } else {
#pragma unroll
                for (int h = 0; h < 2; ++h)
#pragma unroll
                    for (int i = 0; i < 2; ++i) offN[h][i] = offC[h][i];
            }
        }
        _Pragma("nounroll") for (int t = 0; t < nt; t += 2) {
            const bool last = (t == nt - 2);
            const char* a1 = cA + (size_t)(t + 1) * kstepA;
            const char* a2 = last ? nA : cA + (size_t)(t + 2) * kstepA; const char* b2 = last ? nB : cB + (size_t)(t + 2) * kstepB;
            const char* a3 = a2 + kstepA; const char* b3 = b2 + kstepB;
            unsigned o2[2][2];
            if constexpr (GATHER) {
#pragma unroll
                for (int h = 0; h < 2; ++h)
#pragma unroll
                    for (int i = 0; i < 2; ++i) o2[h][i] = last ? offN[h][i] : offC[h][i];
            }
            if constexpr (MIDSCALE) { if (t == nt / 2) E.midscale(acc, ui, wr, fr); }
            PG8_LDB(B0, 0, 0); PG8_LDB(B1, 0, 1); PG8_SCHED; PG8_LDA(At, 0, 0); PG8_STA(PG8_SA(1, 1), a1, 1, offC);
            if constexpr (pg8_tab<Epi>::value) { if (t == 2) E.table_issue(lds, cur, wid, lane); }
            PG8_WAIT_V8T(); PG8_WAIT_L(0); PG8_BAR; PG8_MMA(0, 0, At, B0); PG8_MMA(0, 1, At, B1); PG8_BAR; PG8_SCHED;
            PG8_LDA(At, 0, 1); PG8_STB(PG8_SB(0, 0), b2, 0); PG8_STB(PG8_SB(0, 1), b2, 1); PG8_STA(PG8_SA(0, 0), a2, 0, o2);
            PG8_WAIT_V8T(); PG8_WAIT_L(0); PG8_BAR; PG8_MMA(1, 0, At, B0); PG8_MMA(1, 1, At, B1); PG8_BAR; PG8_SCHED;
            PG8_LDB(B0, 1, 0); PG8_LDB(B1, 1, 1); PG8_SCHED; PG8_LDA(At, 1, 0); PG8_STA(PG8_SA(0, 1), a2, 1, o2);
            PG8_WAIT_V(8); PG8_WAIT_L(0); PG8_BAR; PG8_MMA(0, 0, At, B0); PG8_MMA(0, 1, At, B1); PG8_BAR; PG8_SCHED;
            PG8_LDA(At, 1, 1); PG8_STB(PG8_SB(1, 0), b3, 0); PG8_STB(PG8_SB(1, 1), b3, 1); PG8_STA(PG8_SA(1, 0), a3, 0, o2);
            PG8_WAIT_V(8); PG8_WAIT_L(0); PG8_BAR; PG8_MMA(1, 0, At, B0); PG8_MMA(1, 1, At, B1); PG8_BAR; PG8_SCHED;
        }
        if (wr == 0) PG8_BAR;
        if constexpr (FP8) {
#pragma unroll
            for (int a = 0; a < 2; ++a)
#pragma unroll
                for (int b = 0; b < 2; ++b)
                    asm volatile("s_nop 15\n\ts_nop 15" : "+v"(acc[a][b][0][0]), "+v"(acc[a][b][0][1]), "+v"(acc[a][b][1][0]), "+v"(acc[a][b][1][1]), "+v"(acc[a][b][2][0]), "+v"(acc[a][b][2][1]), "+v"(acc[a][b][3][0]), "+v"(acc[a][b][3][1]));
        }
        E(acc, cur, ui, wr, wc, fr, fq);
        if (!has_next) break;
#pragma unroll
        for (int a = 0; a < 2; ++a)
#pragma unroll
            for (int b = 0; b < 2; ++b)
#pragma unroll
                for (int m = 0; m < 4; ++m)
#pragma unroll
                    for (int n = 0; n < 2; ++n) acc[a][b][m][n] = (f32x4){0.f, 0.f, 0.f, 0.f};
        cur = nxt; cA = nA; cB = nB; ++ui;
        if constexpr (GATHER) {
#pragma unroll
            for (int h = 0; h < 2; ++h)
#pragma unroll
                for (int i = 0; i < 2; ++i) offC[h][i] = offN[h][i];
        }
        if (wr == 1) PG8_BAR;
    }
    PG8_WAIT_V(0);
    PG8_BAR;
#undef PG8_SA
#undef PG8_ABASE
#undef PG8_SB
#undef PG8_STAGE
#undef PG8_STA
#undef PG8_STB
#undef PG8_LDA
#undef PG8_LDB
#undef PG8_MMA
#undef PG8_WAIT_V
#undef PG8_WAIT_V8T
#undef PG8_WAIT_L
#undef PG8_BAR
#undef PG8_SCHED
}
}

#define XB_TMO      128
#define XB_XCNT(j)  (256  + 64 * (j))
#define XB_XSUB(j)  (1280 + 64 * (j))
#define XB_XGEN(j)  (2304 + 64 * (j))
#define XB_TOP      3328
#define XB_TOPGEN   3392
#define XCD_BAR_WORDS 3456
#define XB_SPIN_CAP (1u << 18)

__device__ __forceinline__ unsigned xb_ld(unsigned* p)              { return __hip_atomic_load(p, __ATOMIC_RELAXED, __HIP_MEMORY_SCOPE_AGENT); }
__device__ __forceinline__ unsigned xb_add(unsigned* p, unsigned v) { return __hip_atomic_fetch_add(p, v, __ATOMIC_RELAXED, __HIP_MEMORY_SCOPE_AGENT); }
__device__ __forceinline__ unsigned xb_xcc_id() { return (unsigned)__builtin_amdgcn_s_getreg((3 << 11) | 20) & 0xFu; }
#define XB_SPIN(cond, bar) do { unsigned _sp = 0; while (cond) { __builtin_amdgcn_s_sleep(1); \
    if ((++_sp & 255u) == 0u) { if (xb_ld(&(bar)[XB_TMO])) break; if (_sp > XB_SPIN_CAP) { atomicAdd(&(bar)[XB_TMO], 1u); break; } } } } while (0)

struct XcdBarrier {
    unsigned* bar; unsigned x;
    volatile LAS unsigned* st;
};
__device__ __forceinline__ XcdBarrier xcd_barrier_post(unsigned* bar, volatile LAS unsigned* st) {
    XcdBarrier b; b.bar = bar; b.x = xb_xcc_id(); b.st = st;
    if (threadIdx.x == 0) (void)xb_add(&bar[XB_XCNT(b.x)], 1u);
    return b;
}
__device__ __forceinline__ void xcd_barrier_complete(unsigned* bar, unsigned x, unsigned& nloc, unsigned& nx) {
    const unsigned G = gridDim.x * gridDim.y * gridDim.z;
    unsigned sum, cnt, mine, sp = 0u;
    for (;;) {
        sum = 0u; cnt = 0u; mine = 0u;
#pragma unroll
        for (unsigned j = 0; j < 16; ++j) { const unsigned c = xb_ld(&bar[XB_XCNT(j)]); sum += c; cnt += (c > 0u) ? 1u : 0u; mine = (j == x) ? c : mine; }
        if (sum == G) break;
        __builtin_amdgcn_s_sleep(1);
        if ((++sp & 255u) == 0u) { if (xb_ld(&bar[XB_TMO])) break; if (sp > XB_SPIN_CAP) { atomicAdd(&bar[XB_TMO], 1u); break; } }
    }
    nloc = mine > 0u ? mine : 1u; nx = cnt > 0u ? cnt : 1u;
}
__device__ __forceinline__ void xcd_barrier(const XcdBarrier& b) {
    asm volatile("s_waitcnt vmcnt(0)" ::: "memory");
    __syncthreads();
    if (threadIdx.x == 0) {
        unsigned* bar = b.bar;
        __builtin_amdgcn_s_waitcnt(0);
        unsigned nloc = b.st[0], nx = b.st[1];
        if (nloc == 0u) { xcd_barrier_complete(bar, b.x, nloc, nx); b.st[0] = nloc; b.st[1] = nx; }
        const unsigned old = xb_add(&bar[XB_XSUB(b.x)], 1u);
        const unsigned gen = old / nloc;
        if (old + 1u == (gen + 1u) * nloc) {
            __builtin_amdgcn_fence(__ATOMIC_RELEASE, "agent");
            asm volatile("s_waitcnt vmcnt(0)" ::: "memory");
            const unsigned og = xb_add(&bar[XB_TOP], 1u);
            const unsigned tg = og / nx;
            if (og + 1u == (tg + 1u) * nx) xb_add(&bar[XB_TOPGEN], 1u);
            else XB_SPIN(xb_ld(&bar[XB_TOPGEN]) == tg, bar);
            __builtin_amdgcn_fence(__ATOMIC_ACQUIRE, "agent");
            xb_add(&bar[XB_XGEN(b.x)], 1u);
            asm volatile("s_waitcnt vmcnt(0)" ::: "memory");
        } else {
            XB_SPIN(xb_ld(&bar[XB_XGEN(b.x)]) == gen, bar);
            __builtin_amdgcn_fence(__ATOMIC_ACQUIRE, "agent");
            asm volatile("s_waitcnt vmcnt(0)" ::: "memory");
        }
    }
    __syncthreads();
}

struct Frame {
    LAS unsigned char* lds;
    unsigned* ctl;
    int tid, lane, wave, vcu, G;
    const float* const* in;
    float* out; unsigned char* ws;
};
#define IN_x (F.in[0])
#define IN_c (F.in[1])
#define IN_w_in (F.in[2])
#define IN_w_out (F.in[3])
#define IN_sinks (F.in[4])
#define IN_rel_bias (F.in[5])
#define IN_norm_a (F.in[6])
#define IN_norm_b (F.in[7])
#define IN_w_ada (F.in[8])
#define IN_b_ada (F.in[9])
#define IN_ln1_g (F.in[10])
#define IN_ln1_b (F.in[11])
#define IN_ln2_g (F.in[12])
#define IN_ln2_b (F.in[13])
#define IN_w_grp (F.in[14])
#define IN_b_grp (F.in[15])
#define IN_w_rtr (F.in[16])
#define IN_b_rtr (F.in[17])
#define IN_w_gate (F.in[18])
#define IN_w_up (F.in[19])
#define IN_w_down (F.in[20])

struct CvtItem { const float* src; const float* kgain; bf16* dst0; int ldw, ldd; float scol; };
__device__ __forceinline__ void cvt_load(const CvtItem& it, f32x4 (&a)[8], f32x4 (&b)[8], int lane) {
#pragma unroll
    for (int i = 0; i < 8; ++i) { const int idx = lane + 64 * i, kk2 = idx >> 4, c4 = idx & 15; const float* p = it.src + (size_t)(2 * kk2) * it.ldw + 4 * c4;
        a[i] = __builtin_nontemporal_load((const f32x4*)p); b[i] = __builtin_nontemporal_load((const f32x4*)(p + it.ldw)); }
}
__device__ __forceinline__ void cvt_store(const CvtItem& it, const f32x4 (&a)[8], const f32x4 (&b)[8], LAS unsigned* img, int lane) {
#pragma unroll
    for (int i = 0; i < 8; ++i) { const int idx = lane + 64 * i, kk2 = idx >> 4, c4 = idx & 15; float ga = it.scol, gb = it.scol;
        if (it.kgain) { ga *= it.kgain[2 * kk2]; gb *= it.kgain[2 * kk2 + 1]; }
#pragma unroll
        for (int j = 0; j < 4; ++j) img[(4 * c4 + j) * 33 + kk2] = cvt_pk_bf16(a[i][j] * ga, b[i][j] * gb); }
    LDS_WAIT(); asm volatile("" ::: "memory");
#pragma unroll
    for (int i = 0; i < 8; ++i) { const int idx = lane + 64 * i, n = idx >> 3, ch = idx & 7; const LAS unsigned* s = img + n * 33 + 4 * ch;
        u32x4 v; v.x = s[0]; v.y = s[1]; v.z = s[2]; v.w = s[3];
        *(u32x4*)(it.dst0 + (size_t)n * it.ldd + 8 * ch) = v; }
    LDS_WAIT(); asm volatile("" ::: "memory");
}
constexpr int CVT_I_IN = 32 * 68, CVT_I_OUT = 32 * 32, CVT_NITEMS = CVT_I_IN + CVT_I_OUT;
__device__ __forceinline__ CvtItem cvt_decode(Frame& F, int r) {
    bf16* WIN = (bf16*)(F.ws + WS_WIN); bf16* WOUT = (bf16*)(F.ws + WS_WOUT);
    CvtItem it;
    if (r < CVT_I_IN) { const int kb = r / 68, nb = r % 68, n0 = 64 * nb; it.scol = (n0 < 1024 || (n0 >= COL_QB && n0 < COL_KB)) ? QSCALE : 1.f;
        it.src = IN_w_in + (size_t)(64 * kb) * QKVD + n0; it.ldw = QKVD; it.kgain = nullptr; it.dst0 = WIN + ((size_t)((n0 >> 8) * 32 + kb) * 256 + (n0 & 255)) * 64; it.ldd = 64; return it; }
    r -= CVT_I_IN;
    { const int kb = r / 32, nb = r % 32, k0 = 64 * kb; it.scol = 1.f; it.kgain = k0 < 1024 ? IN_norm_a + k0 : IN_norm_b + (k0 - 1024);
      it.src = IN_w_out + (size_t)k0 * DM + 64 * nb; it.ldw = DM; it.dst0 = WOUT + ((size_t)(((64 * nb) >> 8) * 32 + kb) * 256 + ((64 * nb) & 255)) * 64; it.ldd = 64; return it; }
}
__device__ __forceinline__ void cvt8_item(const float* __restrict__ src, int ldw, float scol, unsigned char* dst0, int ldd, LAS unsigned* img, int lane) {
    f32x4 v[8][4];
#pragma unroll
    for (int i = 0; i < 8; ++i) { const int idx = lane + 64 * i, kk4 = idx >> 4, c4 = idx & 15; const float* p = src + (size_t)(4 * kk4) * ldw + 4 * c4;
#pragma unroll
        for (int q = 0; q < 4; ++q) v[i][q] = __builtin_nontemporal_load((const f32x4*)(p + (size_t)q * ldw)); }
#pragma unroll
    for (int i = 0; i < 8; ++i) { const int idx = lane + 64 * i, kk4 = idx >> 4, c4 = idx & 15;
#pragma unroll
        for (int j = 0; j < 4; ++j) img[(4 * c4 + j) * 33 + kk4] = cvt_fp8x4(v[i][0][j] * scol, v[i][1][j] * scol, v[i][2][j] * scol, v[i][3][j] * scol); }
    LDS_WAIT(); asm volatile("" ::: "memory");
#pragma unroll
    for (int i = 0; i < 8; ++i) { const int idx = lane + 64 * i, n = idx >> 3, ch = idx & 7; const LAS unsigned* sp = img + n * 33 + 4 * ch;
        u32x4 w; w.x = sp[0]; w.y = sp[1]; w.z = sp[2]; w.w = sp[3];
        *(u32x4*)(dst0 + (size_t)n * ldd + 16 * ch) = w; }
    LDS_WAIT(); asm volatile("" ::: "memory");
}

constexpr int CVT8_PRE2 = 2;
constexpr int CVT8_EXTRA = 1024;
constexpr int CVT8_N = 2 * 32 * 16 * 8 + 32 * 4 * 32, CVT8_DEFER2 = 5120, CVT8_DEFER6 = 3328, CVT8_DEFER4 = 2048, QKV_UNITS = (TOK / 256) * (QKVD / 256);
static_assert(CVT8_N - CVT8_DEFER6 >= 2 * 32 * 16 * 8, "the items deferred to the gate/up phase must be down-projection tiles");
__device__ __forceinline__ int cvt8_short(int G) { const int rem = QKV_UNITS % G; return rem == 0 ? 0 : G - rem; }
__device__ __forceinline__ int cvt8_split(int G) { return CVT8_N - CVT8_DEFER6 - (cvt8_short(G) > 0 ? CVT8_DEFER2 : 0) - CVT8_DEFER4; }
__device__ __forceinline__ void cvt8_run(Frame& F, int r, LAS unsigned* img, int lane) {
    unsigned char* WGU = F.ws + WS_WGU; unsigned char* WDN = F.ws + WS_WDN;
    constexpr int I_G = 32 * 16 * 8;
    if (r < 2 * I_G) { const int up = r >= I_G, rr = up ? r - I_G : r; const int e = rr / 128, q = rr % 128, kb = q / 8, nb = q % 8, j0 = 64 * nb;
        const int drow = 256 * (j0 >> 7) + (up ? 128 : 0) + (j0 & 127);
        cvt8_item((up ? IN_w_up : IN_w_gate) + (size_t)e * DM * DEXP + (size_t)(128 * kb) * DEXP + j0, DEXP, W_GU_SCALE, WGU + ((size_t)e * 1024 + drow) * DM + 128 * kb, DM, img, lane);
    } else { const int rr = r - 2 * I_G; const int e = rr / 128, q = rr % 128, kb = q / 32, nb = q % 32;
        cvt8_item(IN_w_down + (size_t)e * DEXP * DM + (size_t)(128 * kb) * DM + 64 * nb, DM, W_DN_SCALE, WDN + ((size_t)e * DM + 64 * nb) * DEXP + 128 * kb, DEXP, img, lane); }
}
__device__ __forceinline__ void cvt8_deferred2(Frame& F, int part) {
    const int ns = cvt8_short(F.G), first = F.G - ns, c = (int)blockIdx.x;
    int lane = F.lane; asm volatile("" : "+v"(lane));
    if (ns > 0 && c >= first) { LAS unsigned* img = (LAS unsigned*)(F.lds + F.wave * 8448); const int lo = cvt8_split(F.G) + CVT8_DEFER4, hi = lo + CVT8_DEFER2, stride = ns * 8;
        const int r0 = lo + (c - first) * 8 + F.wave, rmid = r0 + CVT8_PRE2 * stride;
        if (part == 0) { for (int r = r0; r < hi && r < rmid; r += stride) cvt8_run(F, r, img, lane); }
        else { for (int r = rmid; r < hi; r += stride) cvt8_run(F, r, img, lane); } }
}
__device__ __forceinline__ void cvt8_deferred4(Frame& F) {
    int lane = F.lane; asm volatile("" : "+v"(lane));
    if (F.vcu & 1) { LAS unsigned* img = (LAS unsigned*)(F.lds + F.wave * 8448); const int lo = cvt8_split(F.G), hi = lo + CVT8_DEFER4;
        for (int r = lo + (F.vcu >> 1) * 8 + F.wave; r < hi; r += (F.G >> 1) * 8) cvt8_run(F, r, img, lane); }
}
__device__ __forceinline__ void cvt8_deferred6(Frame& F, int units) {
    const int rem = units % F.G, ns = F.G - rem; const bool all = rem == 0 || ns < 64;
    int lane = F.lane; asm volatile("" : "+v"(lane));
    const int idx = all ? F.vcu : F.vcu - rem, cnt = all ? F.G : ns;
    if (idx >= 0) { LAS unsigned* img = (LAS unsigned*)(F.lds + F.wave * 8448);
        for (int r = CVT8_N - CVT8_DEFER6 + idx * 8 + F.wave; r < CVT8_N; r += cnt * 8) cvt8_run(F, r, img, lane); }
}
__device__ __forceinline__ void p0_prologue(Frame& F) {
    float* mod = (float*)(F.ws + WS_MOD);
    const bool spread = (F.G == 256); const bool freewg = spread && (F.vcu & 3) == 3;
    for (int ab = spread ? (freewg ? 192 : (F.vcu >> 2) * 3 + (F.vcu & 3)) : F.vcu; ab < 192; ab += spread ? 192 : F.G) {
        LAS float* cact = (LAS float*)F.lds;
        for (int idx = F.tid; idx < 16 * 2048; idx += 512) { const int b = idx >> 11, k = idx & 2047; const float v = IN_c[idx]; cact[k * 16 + b] = v * __builtin_amdgcn_rcpf(1.f + __builtin_amdgcn_exp2f(-v * LOG2E)); }
        __syncthreads();
        const int cc = F.lane & 15, kk = F.lane >> 4;
        f32x4 acc[4];
#pragma unroll
        for (int j = 0; j < 4; ++j) acc[j] = (f32x4){0.f, 0.f, 0.f, 0.f};
        const float* wp = IN_w_ada + 64 * ab + 4 * cc + (size_t)(256 * F.wave + kk) * 12288;
        const LAS float* ap = cact + (256 * F.wave + kk) * 16 + cc;
#pragma unroll 16
        for (int st = 0; st < 64; ++st) { const f32x4 w = __builtin_nontemporal_load((const f32x4*)(wp + (size_t)(4 * st) * 12288)); const float av = ap[4 * st * 16];
#pragma unroll
            for (int j = 0; j < 4; ++j) acc[j] = __builtin_amdgcn_mfma_f32_16x16x4f32(av, w[j], acc[j], 0, 0, 0); }
        __syncthreads();
        LAS float* red = (LAS float*)F.lds;
#pragma unroll
        for (int j = 0; j < 4; ++j)
#pragma unroll
            for (int r = 0; r < 4; ++r) red[(F.wave * 16 + 4 * kk + r) * 64 + 4 * cc + j] = acc[j][r];
        __syncthreads();
        for (int o = F.tid; o < 1024; o += 512) { const int b = o >> 6, col = o & 63; float sm = 0.f;
#pragma unroll
            for (int w = 0; w < 8; ++w) sm += red[(w * 16 + b) * 64 + col];
            mod[b * 12288 + 64 * ab + col] = sm + IN_b_ada[64 * ab + col]; }
        __syncthreads();
    }
    { bf16* wh = (bf16*)(F.ws + WS_WR); bf16* wl = wh + 48 * 2048;
      for (int idx = F.vcu * 512 + F.tid; idx < 48 * 2048; idx += F.G * 512) { const int c = idx >> 11, k = idx & 2047;
          const float v = c < 4 ? IN_w_grp[k * 4 + c] : (c < 36 ? IN_w_rtr[k * 32 + (c - 4)] : 0.f);
          const unsigned h = cvt_pk_bf16(v, 0.f) & 0xffffu; const float r = v - bf_lo(h);
          wh[idx] = (bf16)h; wl[idx] = (bf16)(cvt_pk_bf16(r, 0.f) & 0xffffu); } }
    LAS unsigned* img = (LAS unsigned*)(F.lds + F.wave * 8448);
    const int gw = F.vcu * 8 + F.wave, NGW = F.G * 8;
    f32x4 a0[8], b0[8], a1[8], b1[8]; CvtItem i0, i1;
    int it = gw;
    if (it < CVT_NITEMS) { i0 = cvt_decode(F, it); cvt_load(i0, a0, b0, F.lane); }
    for (; it < CVT_NITEMS; it += 2 * NGW) {
        const bool h1 = it + NGW < CVT_NITEMS, h2 = it + 2 * NGW < CVT_NITEMS;
        if (h1) { i1 = cvt_decode(F, it + NGW); cvt_load(i1, a1, b1, F.lane); }
        cvt_store(i0, a0, b0, img, F.lane);
        if (h2) { i0 = cvt_decode(F, it + 2 * NGW); cvt_load(i0, a0, b0, F.lane); }
        if (h1) cvt_store(i1, a1, b1, img, F.lane);
    }
    const int n0 = cvt8_split(F.G), ex = spread ? CVT8_EXTRA : 0;
    if (freewg) for (int r = (F.vcu >> 2) * 8 + F.wave; r < ex; r += 512) cvt8_run(F, r, img, F.lane);
    for (int r = ex + gw; r < n0; r += NGW) cvt8_run(F, r, img, F.lane);
}

__device__ __forceinline__ void p1_modulate(Frame& F) {
    const float* mod = (const float*)(F.ws + WS_MOD); bf16* H = (bf16*)(F.ws + WS_H);
    LAS float* sc = (LAS float*)F.lds; LAS float* sh = sc + 2048;
    for (int blk = F.vcu; blk < 256; blk += F.G) {
        const int b = blk >> 4;
        for (int k = F.tid; k < 2048; k += 512) { sc[k] = 1.f + mod[b * 12288 + 2048 + k]; sh[k] = mod[b * 12288 + k]; }
        if ((blk & 15) == 0) { float* T = (float*)(F.ws + WS_P4TAB) + (size_t)b * 4 * 2048;
            for (int k = F.tid; k < 2048; k += 512) { const float ca = ALPHA_DN / (1.f + mod[b * 12288 + 2048 + k]); T[k] = ca; T[2048 + k] = -mod[b * 12288 + k] * ca; T[4096 + k] = 1.f + mod[b * 12288 + 4096 + k]; T[6144 + k] = 0.f; } }
        __syncthreads();
        for (int r = F.wave; r < 128; r += 16) { const size_t row = (size_t)blk * 128 + r;
            f32x4 xv[2][8];
#pragma unroll
            for (int q = 0; q < 2; ++q)
#pragma unroll
                for (int j = 0; j < 8; ++j) xv[q][j] = __builtin_nontemporal_load((const f32x4*)(IN_x + (row + 8 * q) * DM + 4 * F.lane + 256 * j));
#pragma unroll
            for (int q = 0; q < 2; ++q)
#pragma unroll
                for (int j = 0; j < 8; ++j) { const int col = 4 * F.lane + 256 * j;
                    const f32x4 s4 = *(const LAS f32x4*)(sc + col), t4 = *(const LAS f32x4*)(sh + col); const f32x4 h = xv[q][j] * s4 + t4;
                    u32x2 w; w.x = cvt_pk_bf16(h[0], h[1]); w.y = cvt_pk_bf16(h[2], h[3]); *(u32x2*)(H + ((((row + 8 * q) >> 8) * 32 + (col >> 6)) * 256 + ((row + 8 * q) & 255)) * 64 + (col & 63)) = w; } }
        __syncthreads();
    }
}

struct EpiStoreBf16 {
    static constexpr bool PERM = true, PERM16 = true;
    bf16* O; int ldc; float sc;
    __device__ __forceinline__ void operator()(const f32x4 (&acc)[2][2][4][2], const pg8::Unit& u, int ui, int wr, int wc, int fr, int fq) const {
        const int bb = (u.pm * 256) >> 11, s0 = (u.pm * 256) & 2047;
        bf16* base = O + (((size_t)(u.pn * 4 + wc) * NBATCH + bb) * SEQ + s0 + wr * 64 + fr) * 64 + 16 * fq;
#pragma unroll
        for (int ai = 0; ai < 2; ++ai)
#pragma unroll
            for (int m = 0; m < 4; ++m) { bf16* rowp = base + (size_t)(ai * 128 + m * 16) * 64;
#pragma unroll
                for (int bj = 0; bj < 2; ++bj) { const f32x4 v0 = acc[ai][bj][m][0] * sc, v1 = acc[ai][bj][m][1] * sc;
                    u32x4 w; w.x = cvt_pk_bf16(v0[0], v0[1]); w.y = cvt_pk_bf16(v0[2], v0[3]); w.z = cvt_pk_bf16(v1[0], v1[1]); w.w = cvt_pk_bf16(v1[2], v1[3]);
                    *(u32x4*)(rowp + bj * 8) = w; } }
    }
};
struct EpiStoreFp8 {
    static constexpr bool PERM = true, PERM16 = true;
    unsigned char* O; int ldc; float sc;
    __device__ __forceinline__ void operator()(const f32x4 (&acc)[2][2][4][2], const pg8::Unit& u, int ui, int wr, int wc, int fr, int fq) const {
        const int row0 = u.pm * 256 + wr * 64 + fr, col0 = u.pn * 256 + wc * 64 + 16 * fq;
#pragma unroll
        for (int ai = 0; ai < 2; ++ai)
#pragma unroll
            for (int m = 0; m < 4; ++m) { unsigned char* rowp = O + (size_t)(row0 + ai * 128 + m * 16) * ldc + col0;
                const f32x4 a0 = acc[ai][0][m][0] * sc, a1 = acc[ai][0][m][1] * sc, b0 = acc[ai][1][m][0] * sc, b1 = acc[ai][1][m][1] * sc;
                u32x4 w; w.x = cvt_fp8x4(a0[0], a0[1], a0[2], a0[3]); w.y = cvt_fp8x4(a1[0], a1[1], a1[2], a1[3]); w.z = cvt_fp8x4(b0[0], b0[1], b0[2], b0[3]); w.w = cvt_fp8x4(b1[0], b1[1], b1[2], b1[3]);
                *(u32x4*)rowp = w; }
    }
};
__device__ __forceinline__ float silu_mul(float g, float u) { return g * __builtin_amdgcn_rcpf(1.f + __builtin_amdgcn_exp2f(-g * LOG2E)) * u; }
struct EpiSwiGLU {
    static constexpr bool PERM = true, PERM16 = false;
    unsigned char* ACT;
    __device__ __forceinline__ void operator()(const f32x4 (&acc)[2][2][4][2], const pg8::Unit& u, int ui, int wr, int wc, int fr, int fq) const {
        const int row0 = u.pm * 256 + wr * 64 + fr, col0 = u.pn * 128 + wc * 32 + 8 * fq; constexpr float is = 1.f / W_GU_SCALE;
#pragma unroll
        for (int ai = 0; ai < 2; ++ai)
#pragma unroll
            for (int m = 0; m < 4; ++m) { const f32x4 g0 = acc[ai][0][m][0] * is, g1 = acc[ai][0][m][1] * is, u0 = acc[ai][1][m][0] * (is * ACT_SCALE), u1 = acc[ai][1][m][1] * (is * ACT_SCALE);
                u32x2 w; w.x = cvt_fp8x4(silu_mul(g0[0], u0[0]), silu_mul(g0[1], u0[1]), silu_mul(g0[2], u0[2]), silu_mul(g0[3], u0[3]));
                w.y = cvt_fp8x4(silu_mul(g1[0], u1[0]), silu_mul(g1[1], u1[1]), silu_mul(g1[2], u1[2]), silu_mul(g1[3], u1[3]));
                *(u32x2*)(ACT + (size_t)(row0 + ai * 128 + m * 16) * DEXP + col0) = w; }
    }
};
struct EpiOutProj {
    static constexpr bool PERM = true, PERM16 = false, TABLE = true;
    const bf16* h1; const float* tab; const LAS float* rsL; bf16* y1; float* stats;
    __device__ __forceinline__ void midscale(f32x4 (&acc)[2][2][4][2], int ui, int wr, int fr) const {
#pragma unroll
        for (int ai = 0; ai < 2; ++ai)
#pragma unroll
            for (int m = 0; m < 4; ++m) { const float ratio = rsL[(ui * 256 + ai * 128 + wr * 64 + m * 16 + fr) * 2];
#pragma unroll
                for (int bj = 0; bj < 2; ++bj)
#pragma unroll
                    for (int n = 0; n < 2; ++n) acc[ai][bj][m][n] = acc[ai][bj][m][n] * ratio; }
    }
    __device__ __forceinline__ void table_issue(LAS unsigned char* lds, const pg8::Unit& u, int wid, int lane) const {
        const int b = (u.pm * 256) >> 11;
#pragma unroll
        for (int j = 0; j < 2; ++j) { const int q = 2 * wid + j;
            __builtin_amdgcn_global_load_lds((const unsigned*)(tab + ((size_t)(b * 4 + (q >> 2)) * 2048 + u.pn * 256 + 64 * (q & 3) + lane)), (LAS unsigned*)(lds + P4TAB_OFF + q * 256), 4, 0, 0); }
    }
    __device__ __forceinline__ void operator()(const f32x4 (&acc)[2][2][4][2], const pg8::Unit& u, int ui, int wr, int wc, int fr, int fq) const {
        const int col0 = u.pn * 256 + wc * 32 + 8 * fq;
        const LAS float* T = (const LAS float*)((const LAS unsigned char*)rsL - RS_OFF + P4TAB_OFF) + wc * 32 + 8 * fq;
        constexpr int P4_D = 5;
        u32x4 xq[P4_D][2];
#define P4_ROW(st) ((size_t)u.pm * 256 + ((st) >> 2) * 128 + wr * 64 + ((st) & 3) * 16 + fr)
#define P4_ISSUE(st) do { _Pragma("unroll") for (int bj = 0; bj < 2; ++bj) xq[(st) % P4_D][bj] = *(const u32x4*)(h1t + (size_t)bj * (2 * 256 * 64) + (size_t)((((st) >> 2) * 128 + ((st) & 3) * 16) * 64)); } while (0)
        const bf16* h1t = h1 + ((size_t)(u.pm * 32 + u.pn * 4 + (wc >> 1)) * 256 + wr * 64 + fr) * 64 + (wc & 1) * 32 + 8 * fq;
#pragma unroll
        for (int st = 0; st < P4_D; ++st) P4_ISSUE(st);
        asm volatile("" ::: "memory");
#pragma unroll
        for (int st = 0; st < 8; ++st) { const int ai = st >> 2, m = st & 3; const size_t row = P4_ROW(st); const float rb = rsL[(ui * 256 + ai * 128 + wr * 64 + m * 16 + fr) * 2 + 1]; float s = 0.f, q = 0.f;
#pragma unroll
            for (int bj = 0; bj < 2; ++bj) { const size_t off = row * DM + col0 + bj * 128; const u32x4 xw = xq[st % P4_D][bj];
                f32x4 v[2];
#pragma unroll
                for (int n = 0; n < 2; ++n) { const LAS float* tp = T + bj * 128 + n * 4;
                    const f32x4 ca = *(const LAS f32x4*)tp, cb = *(const LAS f32x4*)(tp + 256), gv = *(const LAS f32x4*)(tp + 512);
                    const unsigned w0 = n ? xw.z : xw.x, w1 = n ? xw.w : xw.y;
                    const f32x4 x4 = (f32x4){bf_lo(w0), bf_hi(w0), bf_lo(w1), bf_hi(w1)};
                    v[n] = (x4 * ca + cb) + gv * (acc[ai][bj][m][n] * rb); }
                const f32x4 v0 = v[0], v1 = v[1];
                u32x4 w; w.x = cvt_pk_bf16(v0[0], v0[1]); w.y = cvt_pk_bf16(v0[2], v0[3]); w.z = cvt_pk_bf16(v1[0], v1[1]); w.w = cvt_pk_bf16(v1[2], v1[3]); *(u32x4*)(y1 + off) = w;
                s += ((v0[0] + v0[1]) + (v0[2] + v0[3])) + ((v1[0] + v1[1]) + (v1[2] + v1[3]));
                q += ((v0[0] * v0[0] + v0[1] * v0[1]) + (v0[2] * v0[2] + v0[3] * v0[3])) + ((v1[0] * v1[0] + v1[1] * v1[1]) + (v1[2] * v1[2] + v1[3] * v1[3])); }
            s += __shfl_xor(s, 16); s += __shfl_xor(s, 32); q += __shfl_xor(q, 16); q += __shfl_xor(q, 32);
            if (fq == 0) *(f32x2*)(stats + (row * 32 + u.pn * 4 + wc) * 2) = (f32x2){s, q};
            if (st + P4_D < 8) P4_ISSUE(st + P4_D);
            asm volatile("" ::: "memory"); }
#undef P4_ROW
#undef P4_ISSUE
    }
};

struct MoeOrder {
    const LAS int* tst; const LAS int* cnt; const int* list; int nN, G, c, NT; const LAS unsigned* rowtab; const LAS int* rte; int xo;
    __device__ __forceinline__ bool next(int i, pg8::Unit& u) const {
        if (xo) {
            const int x4 = (c >> 5) * 4, U = i * 32 + (c & 31), rt = tst[x4] + U / nN;
            if (rt >= tst[x4 + 4]) return false;
            u.pn = U % nN; u.pm = rt; u.e = rte[rt]; return true; }
        const long L = (long)i * G + c; if (L >= (long)NT * nN) return false;
        const int rt = (int)(L / nN); u.pn = (int)(L % nN); u.pm = rt; u.e = rte[rt]; return true;
    }
    __device__ __forceinline__ unsigned row_off(int ui, int r) const { return rowtab[ui * 256 + r]; }
    __device__ __forceinline__ void fill_rowtab(LAS unsigned* tab, int tid) const {
        pg8::Unit u;
        for (int i = 0; i < 8 && next(i, u); ++i) if (tid < 256) { const int pos = (u.pm - tst[u.e]) * 256 + tid; const int tok = pos < cnt[u.e] ? list[u.e * LCAP + pos] : 0; tab[i * 256 + tid] = (unsigned)tok * (unsigned)DM; }
    }
};

__device__ __forceinline__ f32x16 mfma32(bf16x8 a, bf16x8 b, f32x16 c) { return __builtin_amdgcn_mfma_f32_32x32x16_bf16(a, b, c, 0, 0, 0); }
__device__ __forceinline__ void vt_store(LAS unsigned char* wl, const bf16x8 (&vv)[4], int lane) {
    const int key = lane & 31;
#pragma unroll
    for (int i = 0; i < 4; ++i) { const int d8 = (lane >> 5) + 2 * i;
#pragma unroll
        for (int j = 0; j < 8; ++j) *(LAS short*)(wl + (8 * d8 + j) * 80 + key * 2) = vv[i][j]; }
}
__device__ __forceinline__ void pv_tile(f32x16 (&o)[2], LAS unsigned char* wl, const bf16x8 (&pb)[2], int r32, int hi) {
#pragma unroll
    for (int db = 0; db < 2; ++db)
#pragma unroll
        for (int m = 0; m < 2; ++m) { const bf16x8 vf = *(const LAS bf16x8*)(wl + (32 * db + r32) * 80 + (16 * hi + 8 * m) * 2); o[db] = mfma32(vf, pb[m], o[db]); }
}
__device__ __forceinline__ float o_store(const f32x16 (&o)[2], float sc, bf16* orow, int hi) {
    float ss = 0.f;
#pragma unroll
    for (int db = 0; db < 2; ++db)
#pragma unroll
        for (int g = 0; g < 4; ++g) { const float a = o[db][4 * g] * sc, b = o[db][4 * g + 1] * sc, c = o[db][4 * g + 2] * sc, d = o[db][4 * g + 3] * sc;
            ss += (a * a + b * b) + (c * c + d * d); u32x2 w; w.x = cvt_pk_bf16(a, b); w.y = cvt_pk_bf16(c, d); *(u32x2*)(orow + 32 * db + 8 * g + 4 * hi) = w; }
    return ss;
}

constexpr int IMG_PITCH = 144;
__device__ __forceinline__ const bf16* qh_base(const bf16* QH, int g, int b) { return QH + ((size_t)g * NBATCH + b) * SEQ * 64; }
#define WG_BAR() do { asm volatile("s_waitcnt lgkmcnt(0)" ::: "memory"); __builtin_amdgcn_s_barrier(); asm volatile("" ::: "memory"); } while (0)
typedef short v4i16_t __attribute__((ext_vector_type(4)));
__device__ __forceinline__ v4i16_t vtr(const LAS unsigned char* p) { return __builtin_amdgcn_ds_read_tr16_b64_v4i16((LAS v4i16_t*)p); }
__device__ __forceinline__ f32x16 qk_img(const LAS unsigned char* kimg, int row0, int kap, int hi, const bf16x8 (&qr)[4]) {
    const LAS unsigned char* kp = kimg + (row0 + kap) * IMG_PITCH + hi * 16; f32x16 p = {};
#pragma unroll
    for (int s = 0; s < 4; ++s) p = mfma32(*(const LAS bf16x8*)(kp + 32 * s), qr[s], p);
    return p;
}
__device__ __forceinline__ void pv_img(f32x16 (&o)[2], const LAS unsigned char* vimg, int row0, int vlane, const bf16x8 (&pb)[2]) {
    const LAS unsigned char* vp = vimg + row0 * IMG_PITCH + vlane;
#pragma unroll
    for (int db = 0; db < 2; ++db)
#pragma unroll
        for (int m = 0; m < 2; ++m) { const v4i16_t lo = vtr(vp + (8 * m) * IMG_PITCH + 64 * db), hi4 = vtr(vp + (8 * m + 4) * IMG_PITCH + 64 * db);
            const bf16x8 vf = (bf16x8){lo[0], lo[1], lo[2], lo[3], hi4[0], hi4[1], hi4[2], hi4[3]}; o[db] = mfma32(vf, pb[m], o[db]); }
}
__device__ __forceinline__ void pack_p(bf16x8 (&pb)[2], const float (&a)[16]) {
#pragma unroll
    for (int m = 0; m < 2; ++m) { u32x4 w; w.x = cvt_pk_bf16(a[8 * m], a[8 * m + 1]); w.y = cvt_pk_bf16(a[8 * m + 2], a[8 * m + 3]); w.z = cvt_pk_bf16(a[8 * m + 4], a[8 * m + 5]); w.w = cvt_pk_bf16(a[8 * m + 6], a[8 * m + 7]);
        pb[m] = __builtin_bit_cast(bf16x8, w); }
}
template <int NCH, int NROWS> __device__ __forceinline__ void img_issue(u32x4 (&pre)[NCH], const bf16* kbase, const bf16* vbase, int s0, int tid) {
#pragma unroll
    for (int i = 0; i < NCH; ++i) { const int c = tid + 512 * i, mat = c >= NROWS * 8, rem = c - mat * NROWS * 8, row = rem >> 3, ch = rem & 7;
        if (s0 + row >= 0) pre[i] = *(const u32x4*)((mat ? vbase : kbase) + (long)(s0 + row) * 64 + 8 * ch); }
}
template <int NCH, int NROWS> __device__ __forceinline__ void img_write(const u32x4 (&pre)[NCH], LAS unsigned char* img, int s0, int tid) {
#pragma unroll
    for (int i = 0; i < NCH; ++i) { const int c = tid + 512 * i, mat = c >= NROWS * 8, rem = c - mat * NROWS * 8, row = rem >> 3, ch = rem & 7;
        if (s0 + row >= 0) *(LAS u32x4*)(img + mat * NROWS * IMG_PITCH + row * IMG_PITCH + ch * 16) = pre[i]; }
}

constexpr int SWA_ROWS = 160;
__device__ __forceinline__ void swa_phase(Frame& F) {
    const bf16* QKV = (const bf16*)(F.ws + WS_QKV); bf16* O = (bf16*)(F.ws + WS_O); float* ssq = (float*)(F.ws + WS_SSQ);
    const int tid = F.tid, lane = F.lane, r32 = lane & 31, hi = lane >> 5, g = F.wave;
    const int kap = 16 * ((r32 >> 2) & 1) + (r32 & 3) + 4 * (r32 >> 3);
    const int vlane = (16 * hi + ((lane & 15) >> 2)) * IMG_PITCH + (16 * ((lane >> 4) & 1) + 4 * (lane & 3)) * 2;
    LAS unsigned char* kimg = F.lds; LAS unsigned char* vimg = F.lds + SWA_ROWS * IMG_PITCH;
    LAS float* tbl = (LAS float*)(F.lds + 2 * SWA_ROWS * IMG_PITCH) + g * 192;
    const LAS float* tbq = tbl + (r32 - 16 * hi + 17);
    u32x4 pre[5]; bf16x8 qn[4];
    int u = F.vcu; int hq_tbl = -1; float sink2 = 0.f;
    if (u < 2048) { const int b = u >> 7, kv = (u >> 6) & 1, qt = u & 63;
        img_issue<5, SWA_ROWS>(pre, qh_base(QKV, 16 + kv, b), qh_base(QKV, 18 + kv, b), 32 * (qt - 4), tid);
        const bf16* qp = qh_base(QKV, kv * 8 + g, b) + (size_t)(qt * 32 + r32) * 64 + 8 * hi;
#pragma unroll
        for (int s = 0; s < 4; ++s) qn[s] = *(const bf16x8*)(qp + 16 * s); }
    for (; u < 2048; u += F.G) {
        const int b = u >> 7, kv = (u >> 6) & 1, qt = u & 63, hq = kv * 8 + g; const size_t rowb = (size_t)b * SEQ; const int t0 = qt * 32;
        const int j0 = qt >= 4 ? 0 : 4 - qt;
        bf16x8 qr[4];
#pragma unroll
        for (int s = 0; s < 4; ++s) qr[s] = qn[s];
        if (hq != hq_tbl) {
#pragma unroll
            for (int i = 0; i < 3; ++i) { const int n = lane + 64 * i - 32; int bk = n; float tv = 0.f;
                if (n >= 0 && n < 128) { if (n >= 16) { bk = 16 + (int)(logf((float)n * (1.f / 16.f)) / logf(8.f) * 16.f); bk = bk > 31 ? 31 : bk; } tv = IN_rel_bias[bk * 16 + hq] * LOG2E; }
                tbl[n + 32] = tv; }
            sink2 = IN_sinks[hq] * LOG2E; hq_tbl = hq;
        }
        WG_BAR();
        img_write<5, SWA_ROWS>(pre, kimg, 32 * (qt - 4), tid);
        WG_BAR();
        { const int un = u + F.G; if (un < 2048) { const int bn = un >> 7, kvn = (un >> 6) & 1, qtn = un & 63;
            img_issue<5, SWA_ROWS>(pre, qh_base(QKV, 16 + kvn, bn), qh_base(QKV, 18 + kvn, bn), 32 * (qtn - 4), tid);
            const bf16* qp = qh_base(QKV, kvn * 8 + g, bn) + (size_t)(qtn * 32 + r32) * 64 + 8 * hi;
#pragma unroll
            for (int s = 0; s < 4; ++s) qn[s] = *(const bf16x8*)(qp + 16 * s); } }
        f32x16 st[5]; float mx = sink2;
#pragma unroll
        for (int j = 0; j < 5; ++j) {
            if (j < j0) {
#pragma unroll
                for (int r = 0; r < 16; ++r) st[j][r] = -1e30f;
            } else {
                f32x16 p;
#pragma unroll
                for (int r = 0; r < 16; ++r) p[r] = tbq[32 * (4 - j) + 15 - r];
                { const LAS unsigned char* kp = kimg + (32 * j + kap) * IMG_PITCH + hi * 16;
#pragma unroll
                  for (int s = 0; s < 4; ++s) p = mfma32(*(const LAS bf16x8*)(kp + 32 * s), qr[s], p); }
                if (j == 0) {
#pragma unroll
                    for (int r = 0; r < 16; ++r) p[r] = (r >= r32 - 16 * hi + 1) ? p[r] : -1e30f;
                }
                if (j == 4) {
#pragma unroll
                    for (int r = 0; r < 16; ++r) p[r] = (r <= r32 - 16 * hi) ? p[r] : -1e30f;
                }
#pragma unroll
                for (int r = 0; r < 16; ++r) mx = fmaxf(mx, p[r]);
                st[j] = p;
            } }
        mx = fmaxf(mx, __shfl_xor(mx, 32));
        float den = 0.f;
#pragma unroll
        for (int j = 0; j < 5; ++j)
#pragma unroll
            for (int r = 0; r < 16; ++r) { const float e = __builtin_amdgcn_exp2f(st[j][r] - mx); st[j][r] = e; den += e; }
        den += __shfl_xor(den, 32); den += __builtin_amdgcn_exp2f(sink2 - mx);
        f32x16 o[2]; o[0] = (f32x16){}; o[1] = (f32x16){};
#pragma unroll
        for (int j = 0; j < 5; ++j) {
            if (j >= j0) { bf16x8 pb[2]; float a[16];
#pragma unroll
                for (int r = 0; r < 16; ++r) a[r] = st[j][r];
                pack_p(pb, a); pv_img(o, vimg, 32 * j, vlane, pb); } }
        float ss = o_store(o, 1.f / den, O + ((size_t)(b * 32 + hq) * SEQ + t0 + r32) * 64, hi);
        ss += __shfl_xor(ss, 32);
        if (hi == 0) ssq[(rowb + t0 + r32) * 32 + hq] = ss;
    }
    WG_BAR();
}

constexpr int SB_ROWS = 352, SB_BELOW = 3;
constexpr float SB_CUT = 5.421010862427522e-20f;
__device__ __forceinline__ void sb_tile_math(f32x16 p, bool diag, int r32, int hi, float& C, bf16x8 (&pb)[2]) {
    float rr[16], be[16];
#pragma unroll
    for (int r = 0; r < 16; ++r) { const float e = __builtin_amdgcn_exp2f(p[r]); const float q = __builtin_amdgcn_rcpf(1.f + e); rr[r] = q; be[r] = 1.f - q; }
    if (diag) {
#pragma unroll
        for (int r = 0; r < 16; ++r) if (16 * hi + r >= r32) { rr[r] = 1.f; be[r] = 0.f; }
    }
    float run = 1.f, a[16];
#pragma unroll
    for (int r = 15; r >= 0; --r) { a[r] = be[r] * run; run *= rr[r]; }
    const float other = __shfl_xor(run, 32);
    const float base = hi ? C : C * other;
    C = C * run * other; C = C < SB_CUT ? 0.f : C;
#pragma unroll
    for (int r = 0; r < 16; ++r) a[r] *= base;
    pack_p(pb, a);
}
__device__ __forceinline__ void sb_tail(f32x16 (&o)[2], float& C, int kt, const bf16* KH, const bf16* VH, const bf16x8 (&qr)[4], LAS unsigned char* wl, int lane) {
    const int r32 = lane & 31, hi = lane >> 5; const int kap = 16 * ((r32 >> 2) & 1) + (r32 & 3) + 4 * (r32 >> 3);
    for (; kt >= 0; --kt) {
        const bf16* kp = KH + (size_t)(kt * 32 + kap) * 64 + 8 * hi; bf16x8 kf[4];
#pragma unroll
        for (int s = 0; s < 4; ++s) kf[s] = *(const bf16x8*)(kp + 16 * s);
        bf16x8 vv[4];
        { const bf16* vp = VH + (size_t)(kt * 32 + (lane & 31)) * 64 + 8 * (lane >> 5);
#pragma unroll
          for (int i = 0; i < 4; ++i) vv[i] = *(const bf16x8*)(vp + 16 * i); }
        f32x16 p = {};
#pragma unroll
        for (int s = 0; s < 4; ++s) p = mfma32(kf[s], qr[s], p);
        bf16x8 pb[2]; sb_tile_math(p, false, r32, hi, C, pb);
        vt_store(wl, vv, lane); LDS_WAIT();
        pv_tile(o, wl, pb, r32, hi); LDS_WAIT();
        if (__all(C == 0.f)) break;
    }
}
__device__ __forceinline__ void sb_phase(Frame& F) {
    const bf16* QKV = (const bf16*)(F.ws + WS_QKV); bf16* O = (bf16*)(F.ws + WS_O); float* ssq = (float*)(F.ws + WS_SSQ);
    const int tid = F.tid, lane = F.lane, r32 = lane & 31, hi = lane >> 5, w = F.wave;
    const int kap = 16 * ((r32 >> 2) & 1) + (r32 & 3) + 4 * (r32 >> 3);
    const int vlane = (16 * hi + ((lane & 15) >> 2)) * IMG_PITCH + (16 * ((lane >> 4) & 1) + 4 * (lane & 3)) * 2;
    LAS unsigned char* kimg = F.lds; LAS unsigned char* vimg = F.lds + SB_ROWS * IMG_PITCH;
    u32x4 pre[11]; bf16x8 qn[4];
    int u = F.vcu;
    if (u < 2048) { const int b = u >> 7, h = (u >> 3) & 15, qg = u & 7;
        img_issue<11, SB_ROWS>(pre, qh_base(QKV, 36 + h, b), qh_base(QKV, 52 + h, b), 32 * (8 * qg - SB_BELOW), tid);
        const bf16* qp = qh_base(QKV, 20 + h, b) + (size_t)((8 * qg + w) * 32 + r32) * 64 + 8 * hi;
#pragma unroll
        for (int s = 0; s < 4; ++s) qn[s] = *(const bf16x8*)(qp + 16 * s); }
    for (; u < 2048; u += F.G) {
        const int b = u >> 7, h = (u >> 3) & 15, qg = u & 7, qt = 8 * qg + w; const size_t rowb = (size_t)b * SEQ; const int t0 = qt * 32;
        const int tb = 8 * qg - SB_BELOW;
        bf16x8 qr[4];
#pragma unroll
        for (int s = 0; s < 4; ++s) qr[s] = qn[s];
        WG_BAR();
        img_write<11, SB_ROWS>(pre, kimg, 32 * tb, tid);
        WG_BAR();
        { const int un = u + F.G; if (un < 2048) { const int bn = un >> 7, hn = (un >> 3) & 15, qgn = un & 7;
            img_issue<11, SB_ROWS>(pre, qh_base(QKV, 36 + hn, bn), qh_base(QKV, 52 + hn, bn), 32 * (8 * qgn - SB_BELOW), tid);
            const bf16* qp = qh_base(QKV, 20 + hn, bn) + (size_t)((8 * qgn + w) * 32 + r32) * 64 + 8 * hi;
#pragma unroll
            for (int s = 0; s < 4; ++s) qn[s] = *(const bf16x8*)(qp + 16 * s); } }
        f32x16 o[2]; o[0] = (f32x16){}; o[1] = (f32x16){};
        float C = 1.f;
        const int kt_lo = tb > 0 ? tb : 0; int kt = qt;
        for (; kt >= kt_lo; --kt) {
            const f32x16 p = qk_img(kimg, 32 * (kt - tb), kap, hi, qr);
            bf16x8 pb[2]; sb_tile_math(p, kt == qt, r32, hi, C, pb);
            pv_img(o, vimg, 32 * (kt - tb), vlane, pb);
            if (__all(C == 0.f)) { kt = -1; break; }
        }
        WG_BAR();
        if (kt >= 0) sb_tail(o, C, kt, qh_base(QKV, 36 + h, b), qh_base(QKV, 52 + h, b), qr, F.lds + w * 8192, lane);
        float ss = o_store(o, 1.f, O + ((size_t)(b * 32 + 16 + h) * SEQ + t0 + r32) * 64, hi);
        ss += __shfl_xor(ss, 32);
        if (hi == 0) ssq[(rowb + t0 + r32) * 32 + 16 + h] = ss;
    }
    WG_BAR();
}

__device__ __forceinline__ void p3_attention(Frame& F) {
    swa_phase(F);
    sb_phase(F);
}

__device__ __forceinline__ void p5_router(Frame& F) {
    const float* mod = (const float*)(F.ws + WS_MOD); const float* stats = (const float*)(F.ws + WS_STATS); bf16* H = (bf16*)(F.ws + WS_H);
    const bf16* wrh = (const bf16*)(F.ws + WS_WR); const bf16* wrl = wrh + 48 * 2048;
    int* pair_e = (int*)(F.ws + WS_PAIR); int* pair_pos = pair_e + TOK * 2; float* pair_g = (float*)(pair_pos + TOK * 2); float* rowstat = pair_g + TOK * 2; int* list = (int*)(F.ws + WS_LIST);
    LAS float* A2 = (LAS float*)F.lds; LAS float* B2 = A2 + 2048;
    LAS unsigned char* wch = F.lds + 16384;
    LAS float* lg = (LAS float*)(F.lds + 16384 + 2 * 48 * 528 + 512) + F.wave * 768;
    LAS int* wcnt = (LAS int*)(F.lds + 16384 + 2 * 48 * 528 + 512 + 8 * 3072); LAS int* wbase = wcnt + 32;
    LAS int* rowe = wbase + 32; LAS float* rowg = (LAS float*)(rowe + 256); LAS int* rowrank = (LAS int*)(rowg + 256);
    const int lane = F.lane, row16 = lane & 15, kq = lane >> 4;
    for (int blk = F.vcu; blk < 256; blk += F.G) {
        const int b = blk >> 4;
        for (int k = F.tid; k < 2048; k += 512) { const float s2 = 1.f + mod[b * 12288 + 8192 + k]; A2[k] = IN_ln1_g[k] * s2; B2[k] = IN_ln1_b[k] * s2 + mod[b * 12288 + 6144 + k]; }
        if (F.tid < 32) wcnt[F.tid] = 0;
        __syncthreads();
        const size_t row = (size_t)blk * 128 + F.wave * 16 + row16;
        float mean, rstd;
        { float s = 0.f, q = 0.f; const f32x2* sp = (const f32x2*)(stats + row * 64) + kq * 8;
#pragma unroll
          for (int i = 0; i < 8; ++i) { const f32x2 v = sp[i]; s += v.x; q += v.y; }
          s += __shfl_xor(s, 16); s += __shfl_xor(s, 32); q += __shfl_xor(q, 16); q += __shfl_xor(q, 32);
          mean = s * (1.f / DM); const float var = fmaxf(q * (1.f / DM) - mean * mean, 0.f); rstd = 1.f / sqrtf(var + LN_EPS);
          if (kq == 0) *(f32x2*)(rowstat + row * 2) = (f32x2){mean, rstd}; }
        f32x4 acc[3]; acc[0] = (f32x4){0.f, 0.f, 0.f, 0.f}; acc[1] = acc[0]; acc[2] = acc[0];
        const bf16* yrow = (const bf16*)(F.ws + WS_Y1) + row * DM + 8 * kq; unsigned char* hrow = (unsigned char*)H + row * DM + 8 * kq;
        u32x4 wpre[6];
#define P5_WISSUE(kc) do { _Pragma("unroll") for (int i = 0; i < 6; ++i) { const int c = F.tid + 512 * i, mat = c >= 1536, rem = c - mat * 1536, wrow = rem >> 5, ch = rem & 31; \
            wpre[i] = *(const u32x4*)((mat ? wrl : wrh) + (size_t)wrow * 2048 + (kc) + 8 * ch); } } while (0)
#define P5_WWRITE() do { _Pragma("unroll") for (int i = 0; i < 6; ++i) { const int c = F.tid + 512 * i, mat = c >= 1536, rem = c - mat * 1536, wrow = rem >> 5, ch = rem & 31; \
            *(LAS u32x4*)(wch + mat * (48 * 528) + wrow * 528 + ch * 16) = wpre[i]; } } while (0)
        P5_WISSUE(0);
        const LAS unsigned char* bfrag = wch + row16 * 528 + kq * 16;
        u32x4 yc[8], yn[8];
#pragma unroll
        for (int st = 0; st < 8; ++st) yn[st] = *(const u32x4*)(yrow + 32 * st);
        for (int kc = 0; kc < 2048; kc += 256) {
            WG_BAR();
            P5_WWRITE();
            WG_BAR();
#pragma unroll
            for (int st = 0; st < 8; ++st) yc[st] = yn[st];
            if (kc + 256 < 2048) { P5_WISSUE(kc + 256);
#pragma unroll
                for (int st = 0; st < 8; ++st) yn[st] = *(const u32x4*)(yrow + kc + 256 + 32 * st); }
#pragma unroll
            for (int st = 0; st < 8; ++st) { const int k0 = kc + 32 * st;
                const u32x4 yw = yc[st]; const f32x4 y0 = (f32x4){bf_lo(yw.x), bf_hi(yw.x), bf_lo(yw.y), bf_hi(yw.y)}, y1v = (f32x4){bf_lo(yw.z), bf_hi(yw.z), bf_lo(yw.w), bf_hi(yw.w)};
                const f32x4 a0 = *(const LAS f32x4*)(A2 + k0 + 8 * kq), a1 = *(const LAS f32x4*)(A2 + k0 + 8 * kq + 4), b0 = *(const LAS f32x4*)(B2 + k0 + 8 * kq), b1 = *(const LAS f32x4*)(B2 + k0 + 8 * kq + 4);
                const f32x4 h0 = (y0 - mean) * rstd * a0 + b0, h1 = (y1v - mean) * rstd * a1 + b1;
                u32x4 ph; ph.x = cvt_pk_bf16(h0[0], h0[1]); ph.y = cvt_pk_bf16(h0[2], h0[3]); ph.z = cvt_pk_bf16(h1[0], h1[1]); ph.w = cvt_pk_bf16(h1[2], h1[3]);
                { u32x2 h8; h8.x = cvt_fp8x4(h0[0], h0[1], h0[2], h0[3]); h8.y = cvt_fp8x4(h1[0], h1[1], h1[2], h1[3]); *(u32x2*)(hrow + k0) = h8; }
                u32x4 pl; pl.x = cvt_pk_bf16(h0[0] - bf_lo(ph.x), h0[1] - bf_hi(ph.x)); pl.y = cvt_pk_bf16(h0[2] - bf_lo(ph.y), h0[3] - bf_hi(ph.y));
                pl.z = cvt_pk_bf16(h1[0] - bf_lo(ph.z), h1[1] - bf_hi(ph.z)); pl.w = cvt_pk_bf16(h1[2] - bf_lo(ph.w), h1[3] - bf_hi(ph.w));
                const bf16x8 ah = __builtin_bit_cast(bf16x8, ph), al = __builtin_bit_cast(bf16x8, pl);
                bf16x8 wh[3], wl2[3];
#pragma unroll
                for (int cg = 0; cg < 3; ++cg) { wh[cg] = *(const LAS bf16x8*)(bfrag + cg * 16 * 528 + st * 64); wl2[cg] = *(const LAS bf16x8*)(bfrag + 48 * 528 + cg * 16 * 528 + st * 64); }
#pragma unroll
                for (int cg = 0; cg < 3; ++cg) acc[cg] = __builtin_amdgcn_mfma_f32_16x16x32_bf16(ah, wh[cg], acc[cg], 0, 0, 0);
#pragma unroll
                for (int cg = 0; cg < 3; ++cg) acc[cg] = __builtin_amdgcn_mfma_f32_16x16x32_bf16(al, wh[cg], acc[cg], 0, 0, 0);
#pragma unroll
                for (int cg = 0; cg < 3; ++cg) acc[cg] = __builtin_amdgcn_mfma_f32_16x16x32_bf16(ah, wl2[cg], acc[cg], 0, 0, 0); }
        }
#undef P5_WISSUE
#undef P5_WWRITE
#pragma unroll
        for (int cg = 0; cg < 3; ++cg)
#pragma unroll
            for (int i = 0; i < 4; ++i) lg[(4 * kq + i) * 48 + 16 * cg + row16] = acc[cg][i];
        LDS_WAIT();
        if (lane < 16) {
            const LAS float* l = lg + lane * 48; float gl[4];
#pragma unroll
            for (int j = 0; j < 4; ++j) gl[j] = l[j] + IN_b_grp[j];
            int gs = 0; float gm = gl[0];
#pragma unroll
            for (int j = 1; j < 4; ++j) if (gl[j] > gm) { gm = gl[j]; gs = j; }
            float gsum = 0.f;
#pragma unroll
            for (int j = 0; j < 4; ++j) gsum += expf(gl[j] - gm);
            const float pg = 1.f / gsum;
            float v0 = -INFINITY, v1 = -INFINITY; int i0 = 0, i1 = 0;
            for (int j = 0; j < 8; ++j) { const float v = l[4 + 8 * gs + j] + IN_b_rtr[8 * gs + j];
                if (v > v0) { v1 = v0; i1 = i0; v0 = v; i0 = j; } else if (v > v1) { v1 = v; i1 = j; } }
            const float e1 = expf(v1 - v0), inv = 1.f / (1.f + e1);
            const int lr = F.wave * 16 + lane;
            rowe[2 * lr] = 8 * gs + i0; rowe[2 * lr + 1] = 8 * gs + i1; rowg[2 * lr] = pg * inv; rowg[2 * lr + 1] = pg * e1 * inv;
        }
        __syncthreads();
        if (F.tid < 256) rowrank[F.tid] = __hip_atomic_fetch_add(wcnt + rowe[F.tid], 1, __ATOMIC_RELAXED, __HIP_MEMORY_SCOPE_WORKGROUP);
        __syncthreads();
        if (F.tid < 32) wbase[F.tid] = (int)__hip_atomic_fetch_add(F.ctl + CW_CNT + 64 * F.tid, (unsigned)wcnt[F.tid], __ATOMIC_RELAXED, __HIP_MEMORY_SCOPE_AGENT);
        __syncthreads();
        if (F.tid < 256) { const int e = rowe[F.tid], pos = wbase[e] + rowrank[F.tid]; const int tok = blk * 128 + (F.tid >> 1); const size_t pi = (size_t)tok * 2 + (F.tid & 1);
            pair_e[pi] = e; pair_pos[pi] = pos; pair_g[pi] = rowg[F.tid]; list[(size_t)e * LCAP + pos] = tok; }
        __syncthreads();
    }
}

__device__ __forceinline__ int moe_tables(Frame& F) {
    LAS int* tst = (LAS int*)(F.lds + TBL_OFF); LAS int* cnt = tst + 40;
    if (F.tid < 32) cnt[F.tid] = (int)__hip_atomic_load(F.ctl + CW_CNT + 64 * F.tid, __ATOMIC_RELAXED, __HIP_MEMORY_SCOPE_AGENT);
    __syncthreads();
    if (F.tid == 0) { int s = 0; for (int e = 0; e < 32; ++e) { tst[e] = s; s += (cnt[e] + 255) >> 8; } tst[32] = s; }
    __syncthreads();
    if (F.tid < MAXTILES) { int e = 0; while (e < 31 && tst[e + 1] <= F.tid) ++e; ((LAS int*)(F.lds + RTE_OFF))[F.tid] = e; }
    __syncthreads();
    return tst[32];
}

__device__ __forceinline__ void p8_final(Frame& F) {
    const float* mod = (const float*)(F.ws + WS_MOD); const float* stats = (const float*)(F.ws + WS_STATS); const unsigned char* YS = F.ws + WS_YS;
    const int* pair_e = (const int*)(F.ws + WS_PAIR); const int* pair_pos = pair_e + TOK * 2; const float* pair_g = (const float*)(pair_pos + TOK * 2); const float* rowstat = pair_g + TOK * 2;
    const LAS int* tst = (const LAS int*)(F.lds + TBL_OFF);
    LAS float* G1 = (LAS float*)F.lds; LAS float* B1 = G1 + 2048; LAS float* GT = B1 + 2048; LAS float* G2 = GT + 2048; LAS float* Bv2 = G2 + 2048;
    for (int blk = F.vcu; blk < 256; blk += F.G) {
        const int b = blk >> 4;
        for (int k = F.tid; k < 2048; k += 512) { G1[k] = IN_ln1_g[k]; B1[k] = IN_ln1_b[k]; GT[k] = 1.f + mod[b * 12288 + 10240 + k]; G2[k] = IN_ln2_g[k]; Bv2[k] = IN_ln2_b[k]; }
        __syncthreads();
        for (int r = F.wave; r < 128; r += 16) {
            float mean[2], rstd[2], g0[2], g1[2]; size_t s0[2], s1[2]; f32x4 v[2][8]; float sum[2];
#pragma unroll
            for (int q = 0; q < 2; ++q) { const size_t row = (size_t)blk * 128 + r + 8 * q;
                mean[q] = rowstat[row * 2]; rstd[q] = rowstat[row * 2 + 1];
                const int e0 = pair_e[row * 2], e1 = pair_e[row * 2 + 1]; g0[q] = pair_g[row * 2] * (1.f / YS_SCALE); g1[q] = pair_g[row * 2 + 1] * (1.f / YS_SCALE);
                s0[q] = (size_t)tst[e0] * 256 + pair_pos[row * 2]; s1[q] = (size_t)tst[e1] * 256 + pair_pos[row * 2 + 1]; }
            u32x2 yw[2][8]; unsigned ya[2][8], yb[2][8];
#pragma unroll
            for (int q = 0; q < 2; ++q) { const size_t row = (size_t)blk * 128 + r + 8 * q;
#pragma unroll
                for (int j = 0; j < 8; ++j) { const int col = 4 * F.lane + 256 * j; yw[q][j] = *(const u32x2*)((const bf16*)(F.ws + WS_Y1) + row * DM + col);
                    ya[q][j] = *(const unsigned*)(YS + s0[q] * DM + col); yb[q][j] = *(const unsigned*)(YS + s1[q] * DM + col); } }
            asm volatile("" ::: "memory");
#pragma unroll
            for (int q = 0; q < 2; ++q) { sum[q] = 0.f;
#pragma unroll
                for (int j = 0; j < 8; ++j) { const int col = 4 * F.lane + 256 * j; const f32x4 y = (f32x4){bf_lo(yw[q][j].x), bf_hi(yw[q][j].x), bf_lo(yw[q][j].y), bf_hi(yw[q][j].y)};
                    const f32x2 al = __builtin_amdgcn_cvt_pk_f32_fp8((int)ya[q][j], false), ah = __builtin_amdgcn_cvt_pk_f32_fp8((int)ya[q][j], true), bl = __builtin_amdgcn_cvt_pk_f32_fp8((int)yb[q][j], false), bh = __builtin_amdgcn_cvt_pk_f32_fp8((int)yb[q][j], true);
                    const f32x4 fa = (f32x4){al.x, al.y, ah.x, ah.y}, fb = (f32x4){bl.x, bl.y, bh.x, bh.y};
                    const f32x4 x1 = (y - mean[q]) * rstd[q] * *(const LAS f32x4*)(G1 + col) + *(const LAS f32x4*)(B1 + col);
                    v[q][j] = x1 * ALPHA_DN + *(const LAS f32x4*)(GT + col) * (fa * g0[q] + fb * g1[q]); sum[q] += (v[q][j][0] + v[q][j][1]) + (v[q][j][2] + v[q][j][3]);
                    if (j & 1) asm volatile("" ::: "memory"); } }
            float m2[2], sq[2], r2[2];
#pragma unroll
            for (int q = 0; q < 2; ++q) { m2[q] = wave_sum(sum[q]) * (1.f / DM); sq[q] = 0.f;
#pragma unroll
                for (int j = 0; j < 8; ++j) { v[q][j] = v[q][j] - m2[q]; sq[q] += (v[q][j][0] * v[q][j][0] + v[q][j][1] * v[q][j][1]) + (v[q][j][2] * v[q][j][2] + v[q][j][3] * v[q][j][3]); } }
#pragma unroll
            for (int q = 0; q < 2; ++q) { const size_t row = (size_t)blk * 128 + r + 8 * q; r2[q] = 1.f / sqrtf(wave_sum(sq[q]) * (1.f / DM) + LN_EPS);
#pragma unroll
                for (int j = 0; j < 8; ++j) { const int col = 4 * F.lane + 256 * j; __builtin_nontemporal_store(v[q][j] * r2[q] * *(const LAS f32x4*)(G2 + col) + *(const LAS f32x4*)(Bv2 + col), (f32x4*)(F.out + row * DM + col)); } } }
        __syncthreads();
    }
}

struct Args { const float* in[21]; float* out; unsigned char* ws; };
__global__ void __launch_bounds__(512, 2) hybrid_fwd(Args args) {
    extern __shared__ __attribute__((aligned(16))) unsigned char lds[];
    Frame F;
    F.lds = (LAS unsigned char*)lds;
    F.tid = threadIdx.x; F.lane = F.tid & 63; F.wave = __builtin_amdgcn_readfirstlane(F.tid >> 6);
    F.G = gridDim.x; { const int bx = blockIdx.x; F.vcu = (F.G % 8 == 0) ? (bx % 8) * (F.G / 8) + bx / 8 : bx; }
    F.ws = args.ws; F.out = args.out; F.ctl = (unsigned*)(args.ws + WS_CTL);
    F.in = args.in;
    volatile LAS unsigned* MISC = (volatile LAS unsigned*)(F.lds + MISC_OFF);
    if (F.tid < 32) MISC[F.tid] = 0u;
    __syncthreads();
    XcdBarrier bar = xcd_barrier_post(F.ctl + CW_BAR, MISC + 8);

#ifndef PHMASK
#define PHMASK 0x1ff
#endif
#ifndef REPMASK
#define REPMASK 0
#endif
#define REFRESH() do { int t_ = threadIdx.x; asm volatile("" : "+v"(t_)); F.tid = t_; F.lane = t_ & 63; } while (0)
#define PH(n) if constexpr (((PHMASK) >> (n)) & 1) _Pragma("nounroll") for (int rep_ = 0; rep_ < 1 + (((REPMASK) >> (n)) & 1); ++rep_, __syncthreads())
    REFRESH();
    PH(0) p0_prologue(F);
    xcd_barrier(bar);
    REFRESH();
    PH(1) p1_modulate(F);
    xcd_barrier(bar);
    REFRESH();
    PH(2) { pg8::Gemm g{(const bf16*)(F.ws + WS_H), (const bf16*)(F.ws + WS_WIN), DM, 0}; pg8::StaticOrder S; S.init(TOK, QKVD, F.G, (int)blockIdx.x);
      EpiStoreBf16 E{(bf16*)(F.ws + WS_QKV), QKVD, 1.f};
      cvt8_deferred2(F, 0); __syncthreads();
      pg8::gemm_phase<EpiStoreBf16, pg8::StaticOrder, false, false, false, false, true, true>(F.lds, g, S, E);
      cvt8_deferred2(F, 1); }
    xcd_barrier(bar);
    REFRESH();
    PH(3) p3_attention(F);
    xcd_barrier(bar);
    REFRESH();
    PH(4) { pg8::Gemm g{(const bf16*)(F.ws + WS_O), (const bf16*)(F.ws + WS_WOUT), DM, 0}; pg8::StaticOrder S; S.init(TOK, DM, F.G, (int)blockIdx.x);
      cvt8_deferred4(F);
      LAS float* rsL = (LAS float*)(F.lds + RS_OFF); const float* ssq = (const float*)(F.ws + WS_SSQ);
      { pg8::Unit u;
        for (int i = 0; i < 4 && S.next(i, u); ++i) if (F.tid < 256) { const f32x4* sp = (const f32x4*)(ssq + (size_t)(u.pm * 256 + F.tid) * 32); float sa = 0.f, sb = 0.f;
#pragma unroll
            for (int j = 0; j < 4; ++j) { const f32x4 va = sp[j], vb = sp[4 + j]; sa += (va[0] + va[1]) + (va[2] + va[3]); sb += (vb[0] + vb[1]) + (vb[2] + vb[3]); }
            const float ra = 1.f / sqrtf(sa * (1.f / 1024.f) + LN_EPS), rb = 1.f / sqrtf(sb * (1.f / 1024.f) + LN_EPS);
            rsL[(i * 256 + F.tid) * 2] = ra / rb; rsL[(i * 256 + F.tid) * 2 + 1] = rb; } }
      __syncthreads();
      EpiOutProj E{(const bf16*)(F.ws + WS_H), (const float*)(F.ws + WS_P4TAB), rsL, (bf16*)(F.ws + WS_Y1), (float*)(F.ws + WS_STATS)};
      pg8::gemm_phase<EpiOutProj, pg8::StaticOrder, false, true, false, true, false, true>(F.lds, g, S, E); }
    xcd_barrier(bar);
    REFRESH();
    PH(5) p5_router(F);
    xcd_barrier(bar);
    REFRESH();
    const int NT = moe_tables(F);
    REFRESH();
    PH(6) { pg8::Gemm g{(const bf16*)(F.ws + WS_H), (const bf16*)(F.ws + WS_WGU), DM / 2, (size_t)1024 * DM};
      MoeOrder S{(const LAS int*)(F.lds + TBL_OFF), (const LAS int*)(F.lds + TBL_OFF) + 40, (const int*)(F.ws + WS_LIST), 4, F.G, F.vcu, NT, (const LAS unsigned*)(F.lds + RS_OFF), (const LAS int*)(F.lds + RTE_OFF), 0};
      S.fill_rowtab((LAS unsigned*)(F.lds + RS_OFF), F.tid); __syncthreads();
      EpiSwiGLU E{F.ws + WS_ACT};
      pg8::gemm_phase<EpiSwiGLU, MoeOrder, true, false, true>(F.lds, g, S, E);
      cvt8_deferred6(F, NT * 4); }
    xcd_barrier(bar);
    REFRESH();
    PH(7) { pg8::Gemm g{(const bf16*)(F.ws + WS_ACT), (const bf16*)(F.ws + WS_WDN), DEXP / 2, (size_t)DM * DEXP};
      MoeOrder S{(const LAS int*)(F.lds + TBL_OFF), (const LAS int*)(F.lds + TBL_OFF) + 40, (const int*)(F.ws + WS_LIST), 8, F.G, F.vcu, NT, (const LAS unsigned*)(F.lds + RS_OFF), (const LAS int*)(F.lds + RTE_OFF), 0};
      EpiStoreFp8 E{F.ws + WS_YS, DM, YS_SCALE / (ACT_SCALE * W_DN_SCALE)};
      pg8::gemm_phase<EpiStoreFp8, MoeOrder, false, false, true>(F.lds, g, S, E); }
    xcd_barrier(bar);
    REFRESH();
    PH(8) p8_final(F);
}

extern "C" void kernel_launch(void* const* d_in, const int* in_sizes, int n_in, void* d_out, int out_size, void* d_ws, size_t ws_size, hipStream_t stream) {
    static int grid = 0;
    if (grid == 0) {
        if (n_in != 21 || out_size != TOK * DM || ws_size < WS_END) { fprintf(stderr, "kernel_launch: unexpected problem shape (n_in %d, out %d, ws %zu)\n", n_in, out_size, ws_size); grid = -1; return; }
        int dev = 0, cus = 0, per_cu = 0;
        if (hipGetDevice(&dev) != hipSuccess || hipDeviceGetAttribute(&cus, hipDeviceAttributeMultiprocessorCount, dev) != hipSuccess) { grid = -1; return; }
        if (hipFuncSetAttribute((const void*)hybrid_fwd, hipFuncAttributeMaxDynamicSharedMemorySize, LDS_BYTES) != hipSuccess) { fprintf(stderr, "kernel_launch: hipFuncSetAttribute failed\n"); grid = -1; return; }
        if (hipOccupancyMaxActiveBlocksPerMultiprocessor(&per_cu, (const void*)hybrid_fwd, 512, LDS_BYTES) != hipSuccess || per_cu < 1) { fprintf(stderr, "kernel_launch: occupancy query reports %d\n", per_cu); }
        (void)hipGetLastError();
        grid = cus;
    }
    if (grid < 0) return;
    if (hipMemsetAsync((char*)d_ws + WS_CTL, 0, CTL_ZERO_BYTES, stream) != hipSuccess) return;
    Args a{};
    for (int i = 0; i < 21; ++i) a.in[i] = (const float*)d_in[i];
    a.out = (float*)d_out; a.ws = (unsigned char*)d_ws;
    hipLaunchKernelGGL(hybrid_fwd, dim3(grid), dim3(512), LDS_BYTES, stream, a);
}
```
